# Optimizing an MI355X kernel written in HIP

```python
import jax, jax.numpy as jnp
from jax import lax
import numpy as np

D_MODEL = 1024
BATCH = 16
SEQ = 4096
DEPTH = 4

HEAD_DIM = 64
ROPE_THETA = 10000.0
NORM_EPS = 1e-6
BLOCK = 128
NEG_INF = -1e30

A_Q_HEADS = 6
A_KV_HEADS = 2
A_WINDOW = 128
A_WIDTH = A_Q_HEADS * HEAD_DIM

B_HEADS = 6
B_Q_RANK = 384
B_KV_RANK = 256
B_NOPE = 64
B_ROPE = 32
B_V = 64
B_WIDTH = B_HEADS * B_V

C_GROUPS = 4
C_GROUP_DIM = 64
C_WIDTH = C_GROUPS * C_GROUP_DIM
C_CHUNK = 128

MIX_WIDTH = A_WIDTH + B_WIDTH + C_WIDTH
IN_SIZES = (A_WIDTH, A_KV_HEADS * HEAD_DIM, A_KV_HEADS * HEAD_DIM,
            B_Q_RANK, B_KV_RANK, B_ROPE, C_WIDTH, C_WIDTH)
IN_COLS = A_WIDTH + 2 * A_KV_HEADS * HEAD_DIM + B_Q_RANK + B_KV_RANK + B_ROPE + 2 * C_WIDTH

FFN_HIDDEN = ((8 * D_MODEL // 3 + 255) // 256) * 256
N_MOD = 6

kernel_name = "hybrid_parallel_swa_mla_sgu_block"


def rms_norm(x, w):
    xf = x.astype(jnp.float32)
    y = xf * lax.rsqrt(jnp.mean(xf * xf, axis=-1, keepdims=True) + NORM_EPS)
    return (y * w.astype(jnp.float32)).astype(x.dtype)


def layer_norm(x, w, b):
    xf = x.astype(jnp.float32)
    mu = jnp.mean(xf, axis=-1, keepdims=True)
    var = jnp.mean(jnp.square(xf - mu), axis=-1, keepdims=True)
    y = (xf - mu) * lax.rsqrt(var + NORM_EPS)
    return (y * w.astype(jnp.float32) + b.astype(jnp.float32)).astype(x.dtype)


def rope_tables(positions, dim):
    inv = 1.0 / (ROPE_THETA ** (jnp.arange(0, dim, 2, dtype=jnp.float32) / dim))
    ang = positions.astype(jnp.float32)[..., None] * inv
    return jnp.cos(ang), jnp.sin(ang)


def apply_rope(x, cos, sin):
    x1, x2 = jnp.split(x, 2, axis=-1)
    c = cos[:, :, None, :].astype(x.dtype)
    s = sin[:, :, None, :].astype(x.dtype)
    return jnp.concatenate([x1 * c - x2 * s, x2 * c + x1 * s], axis=-1)


def sliding_window_gqa(q, k, v, sinks):
    b_, s_, hq, d = q.shape
    g = hq // A_KV_HEADS
    nb = s_ // BLOCK
    qb = q.reshape(b_, nb, BLOCK, A_KV_HEADS, g, d)
    pad = ((0, 0), (BLOCK, 0), (0, 0), (0, 0))
    kb = jnp.pad(k, pad).reshape(b_, nb + 1, BLOCK, A_KV_HEADS, d)
    vb = jnp.pad(v, pad).reshape(b_, nb + 1, BLOCK, A_KV_HEADS, d)
    kcat = jnp.concatenate([kb[:, :-1], kb[:, 1:]], axis=2)
    vcat = jnp.concatenate([vb[:, :-1], vb[:, 1:]], axis=2)
    scores = jnp.einsum('bnqhgd,bnkhd->bnhgqk', qb, kcat).astype(jnp.float32) * (d ** -0.5)
    qi = jnp.arange(BLOCK)[:, None]
    kj = jnp.arange(2 * BLOCK)[None, :]
    rel = qi + BLOCK - kj
    band = (rel >= 0) & (rel < A_WINDOW)
    not_pad = (jnp.arange(nb)[:, None, None] > 0) | (kj[None] >= BLOCK)
    mask = (band[None] & not_pad)[None, :, None, None]
    scores = jnp.where(mask, scores, NEG_INF)
    sink = sinks.astype(jnp.float32).reshape(A_KV_HEADS, g)[None, None, :, :, None, None]
    m = jnp.maximum(jnp.max(scores, axis=-1, keepdims=True), sink)
    p = jnp.exp(scores - m)
    p = p / (jnp.sum(p, axis=-1, keepdims=True) + jnp.exp(sink - m))
    out = jnp.einsum('bnhgqk,bnkhd->bnqhgd', p.astype(v.dtype), vcat)
    return out.reshape(b_, s_, hq * d)


def mla(c_q, c_kv, k_rope, q_norm_w, w_uq, kv_norm_w, w_ukv, cos, sin):
    b_, s_, _ = c_q.shape
    q = (rms_norm(c_q, q_norm_w) @ w_uq).reshape(b_, s_, B_HEADS, B_NOPE + B_ROPE)
    q_nope, q_rope = q[..., :B_NOPE], q[..., B_NOPE:]
    q_rope = apply_rope(q_rope, cos, sin)
    kv = (rms_norm(c_kv, kv_norm_w) @ w_ukv).reshape(b_, s_, B_HEADS, B_NOPE + B_V)
    k_nope, v = kv[..., :B_NOPE], kv[..., B_NOPE:]
    k_r = apply_rope(k_rope[:, :, None, :], cos, sin)[:, :, 0, :]
    scale = (B_NOPE + B_ROPE) ** -0.5
    nb = s_ // BLOCK
    qn = q_nope.reshape(b_, nb, BLOCK, B_HEADS, B_NOPE).transpose(1, 0, 2, 3, 4)
    qr = q_rope.reshape(b_, nb, BLOCK, B_HEADS, B_ROPE).transpose(1, 0, 2, 3, 4)
    key_pos = jnp.arange(s_)

    def one_block(args):
        qn_b, qr_b, n = args
        sc = (jnp.einsum('bqhd,bkhd->bhqk', qn_b, k_nope)
              + jnp.einsum('bqhd,bkd->bhqk', qr_b, k_r)).astype(jnp.float32) * scale
        qpos = n * BLOCK + jnp.arange(BLOCK)
        sc = jnp.where(key_pos[None, :] <= qpos[:, None], sc, NEG_INF)
        p = jax.nn.softmax(sc, axis=-1)
        return jnp.einsum('bhqk,bkhd->bqhd', p.astype(v.dtype), v)

    out = lax.map(one_block, (qn, qr, jnp.arange(nb)))
    return out.transpose(1, 0, 2, 3, 4).reshape(b_, s_, B_WIDTH)


def chunked_spatial_gating(u, v, ln_w, ln_b, w_s, b_s):
    v = layer_norm(v, ln_w, ln_b)
    b_, s_, _ = v.shape
    nc = s_ // C_CHUNK
    vc = v.reshape(b_, nc, C_CHUNK, C_GROUPS, C_GROUP_DIM)
    tri = jnp.tril(jnp.ones((C_CHUNK, C_CHUNK), dtype=bool))
    w = jnp.where(tri[None], w_s, jnp.zeros_like(w_s))
    mixed = jnp.einsum('gts,bnsgd->bntgd', w, vc) + b_s.T[None, None, :, :, None]
    return u * mixed.reshape(b_, s_, C_WIDTH)


def setup_inputs(seed: int = 0) -> dict:
    key = jax.random.key(seed)
    ks = jax.random.split(key, 24)
    nrm = lambda k, shape, s: jax.random.normal(k, shape, dtype=jnp.float32) * s
    gain = lambda k, shape: 1.0 + nrm(k, shape, 0.02)
    x = nrm(ks[0], (BATCH, SEQ, D_MODEL), 1.0)
    c = nrm(ks[1], (BATCH, D_MODEL), 1.0)
    offs = jax.random.randint(ks[2], (BATCH,), 0, 1024, dtype=jnp.int32)
    positions = offs[:, None] + jnp.arange(SEQ, dtype=jnp.int32)[None, :]
    return {
        "x": x,
        "c": c,
        "positions": positions,
        "ada_w": nrm(ks[3], (DEPTH, D_MODEL, N_MOD * D_MODEL), 0.5 * D_MODEL ** -0.5),
        "ada_b": nrm(ks[4], (DEPTH, N_MOD * D_MODEL), 0.02),
        "norm1_w": gain(ks[5], (DEPTH, D_MODEL)),
        "w_in": nrm(ks[6], (DEPTH, D_MODEL, IN_COLS), D_MODEL ** -0.5),
        "a_sinks": nrm(ks[7], (DEPTH, A_Q_HEADS), 0.5),
        "b_q_norm_w": gain(ks[8], (DEPTH, B_Q_RANK)),
        "b_w_uq": nrm(ks[9], (DEPTH, B_Q_RANK, B_HEADS * (B_NOPE + B_ROPE)), B_Q_RANK ** -0.5),
        "b_kv_norm_w": gain(ks[10], (DEPTH, B_KV_RANK)),
        "b_w_ukv": nrm(ks[11], (DEPTH, B_KV_RANK, B_HEADS * (B_NOPE + B_V)), B_KV_RANK ** -0.5),
        "c_ln_w": gain(ks[12], (DEPTH, C_WIDTH)),
        "c_ln_b": nrm(ks[13], (DEPTH, C_WIDTH), 0.02),
        "c_w_s": nrm(ks[14], (DEPTH, C_GROUPS, C_CHUNK, C_CHUNK), C_CHUNK ** -0.5),
        "c_b_s": gain(ks[15], (DEPTH, C_GROUPS, C_CHUNK)),
        "out_norm_w": gain(ks[16], (DEPTH, MIX_WIDTH)),
        "w_out": nrm(ks[17], (DEPTH, MIX_WIDTH, D_MODEL), MIX_WIDTH ** -0.5),
        "norm2_w": gain(ks[18], (DEPTH, D_MODEL)),
        "w_gate_up": nrm(ks[19], (DEPTH, D_MODEL, 2 * FFN_HIDDEN), D_MODEL ** -0.5),
        "w_down": nrm(ks[20], (DEPTH, FFN_HIDDEN, D_MODEL), FFN_HIDDEN ** -0.5),
        "final_norm_w": gain(ks[21], (D_MODEL,)),
    }


def reference(x, c, positions, ada_w, ada_b, norm1_w, w_in, a_sinks, b_q_norm_w, b_w_uq,
              b_kv_norm_w, b_w_ukv, c_ln_w, c_ln_b, c_w_s, c_b_s, out_norm_w, w_out,
              norm2_w, w_gate_up, w_down, final_norm_w):
    b_, s_, _ = x.shape
    cos_a, sin_a = rope_tables(positions, HEAD_DIM)
    cos_b, sin_b = rope_tables(positions, B_ROPE)
    split_at = np.cumsum(IN_SIZES)[:-1].tolist()
    c_act = jax.nn.silu(c)
    for l in range(DEPTH):
        mod = (c_act @ ada_w[l] + ada_b[l])[:, None, :]
        sh1, sc1, g1, sh2, sc2, g2 = jnp.split(mod, N_MOD, axis=-1)

        h = rms_norm(x, norm1_w[l]) * (1.0 + sc1) + sh1
        proj = h @ w_in[l]
        a_q, a_k, a_v, b_cq, b_ckv, b_kr, c_u, c_v = jnp.split(proj, split_at, axis=-1)

        qa = apply_rope(a_q.reshape(b_, s_, A_Q_HEADS, HEAD_DIM), cos_a, sin_a)
        ka = apply_rope(a_k.reshape(b_, s_, A_KV_HEADS, HEAD_DIM), cos_a, sin_a)
        va = a_v.reshape(b_, s_, A_KV_HEADS, HEAD_DIM)
        y_a = sliding_window_gqa(qa, ka, va, a_sinks[l])

        y_b = mla(b_cq, b_ckv, b_kr, b_q_norm_w[l], b_w_uq[l], b_kv_norm_w[l], b_w_ukv[l],
                  cos_b, sin_b)

        y_c = chunked_spatial_gating(jax.nn.gelu(c_u, approximate=False),
                                     jax.nn.gelu(c_v, approximate=False),
                                     c_ln_w[l], c_ln_b[l], c_w_s[l], c_b_s[l])

        gw = out_norm_w[l]
        y = jnp.concatenate([
            rms_norm(y_a, gw[:A_WIDTH]),
            rms_norm(y_b, gw[A_WIDTH:A_WIDTH + B_WIDTH]),
            rms_norm(y_c, gw[A_WIDTH + B_WIDTH:]),
        ], axis=-1)
        x = x + g1 * (y @ w_out[l])

        h = rms_norm(x, norm2_w[l]) * (1.0 + sc2) + sh2
        gate, up = jnp.split(h @ w_gate_up[l], 2, axis=-1)
        x = x + g2 * ((jax.nn.silu(gate) * up) @ w_down[l])
    return rms_norm(x, final_norm_w)
```

```cpp
#include <hip/hip_runtime.h>
#include <hip/hip_cooperative_groups.h>
#include <cstdio>
#include <cstdint>
#include <cmath>
namespace cg = cooperative_groups;
#ifndef EN_PRO
#define EN_PRO 1
#endif
#ifndef EN_P1
#define EN_P1 1
#endif
#ifndef EN_P2
#define EN_P2 1
#endif
#ifndef EN_P3A
#define EN_P3A 1
#endif
#ifndef EN_P3B
#define EN_P3B 1
#endif
#ifndef EN_P3C
#define EN_P3C 1
#endif
#ifndef EN_P3D
#define EN_P3D 1
#endif
#ifndef EN_P4
#define EN_P4 1
#endif
#ifndef EN_P5
#define EN_P5 1
#endif
#ifndef EN_P6
#define EN_P6 1
#endif
#ifndef EN_P7
#define EN_P7 1
#endif
#ifndef EN_P8
#define EN_P8 1
#endif
#ifndef EN_P9
#define EN_P9 1
#endif
#ifndef EN_FIN
#define EN_FIN 1
#endif
#ifndef REP_PASS
#define REP_PASS 1
#endif
#ifndef REP_SWA
#define REP_SWA 1
#endif
#ifndef REP_SGU
#define REP_SGU 1
#endif
#ifndef REP_G2
#define REP_G2 1
#endif
#ifndef REP_G3
#define REP_G3 1
#endif
#ifndef REP_G8
#define REP_G8 1
#endif
#ifndef REP_PRO
#define REP_PRO 1
#endif
#ifndef REP_SYNC
#define REP_SYNC 1
#endif
#ifndef REP_P9
#define REP_P9 1
#endif
#ifndef REP_P6
#define REP_P6 1
#endif
#ifndef REP_P4
#define REP_P4 1
#endif
#ifndef MK_MULTI
#define MK_MULTI 0
#endif

#define LAS __attribute__((address_space(3)))
typedef unsigned short bf16_t;
typedef short bf16x8 __attribute__((ext_vector_type(8)));
typedef float f32x4 __attribute__((ext_vector_type(4)));
typedef float f32x2 __attribute__((ext_vector_type(2)));
typedef float f32x16 __attribute__((ext_vector_type(16)));
typedef unsigned u32x4 __attribute__((ext_vector_type(4)));
typedef unsigned u32x2 __attribute__((ext_vector_type(2)));

constexpr int DM = 1024, NBATCH = 16, SEQ = 4096, DEPTH = 4, MTOK = NBATCH * SEQ;
constexpr int INC = 1824, PJ = 2048, FFN = 2816, NMOD = 6 * DM;
constexpr int PJP = PJ + 64;
constexpr int PC_AQ = 0, PC_AK = 384, PC_AV = 512, PC_KR = 640, PC_CQ = 768, PC_CKV = 1152, PC_CU = 1536, PC_CV = 1792;
constexpr int QMP = 768, KVP = 768;
constexpr float EPS = 1e-6f;
constexpr float LOG2E = 1.4426950408889634f;
constexpr float QS_A = 0.125f * LOG2E;
constexpr float QS_B = 0.10206207261596575f * LOG2E;
constexpr int NWAVES = 8, NTHR = 512;
constexpr int LDS_BYTES = 147456;

constexpr size_t MiB = 1u << 20;
constexpr size_t WS_WIN = 0, WS_WUQ = 16 * MiB, WS_WUKV = 19 * MiB, WS_WOUT = 21 * MiB, WS_WGU = 29 * MiB, WS_WDN = 73 * MiB, WS_WS = 95 * MiB;
constexpr size_t WS_MOD = 96 * MiB, WS_ROPA = 98 * MiB, WS_ROPB = 114 * MiB;
constexpr size_t WS_H = 128 * MiB, WS_PROJ = 256 * MiB, WS_QM = 520 * MiB, WS_KVM = 616 * MiB, WS_Y = 712 * MiB, WS_HID = 256 * MiB, WS_CTL = 840 * MiB, WS_SHW = 845 * MiB, WS_XG = 848 * MiB, WS_SSQ = 976 * MiB, WS_END = 1008 * MiB;
constexpr size_t CTL_BYTES = 65536;
constexpr int MISC_OFF = 131072 + 320;
constexpr size_t WIN_L = (size_t)PJ * DM, WUQ_L = (size_t)768 * 384, WUKV_L = (size_t)768 * 256, WOUT_L = (size_t)DM * DM, WGU_L = (size_t)2 * FFN * DM, WDN_L = (size_t)DM * FFN, WS_L = (size_t)4 * 128 * 128;

struct Args {
    const float* in[22];
    float* out; unsigned char* ws;
    float inv[48];
    int ph_lo, ph_hi;
};

__device__ __forceinline__ int opaque_tid(int wave_s) { int l; asm volatile("v_mbcnt_lo_u32_b32 %0, -1, 0\n\tv_mbcnt_hi_u32_b32 %0, -1, %0" : "=v"(l)); return (wave_s << 6) | l; }
__device__ __forceinline__ unsigned cvtpk(float lo, float hi) { unsigned r; asm volatile("v_cvt_pk_bf16_f32 %0, %1, %2" : "=v"(r) : "v"(lo), "v"(hi)); return r; }
__device__ __forceinline__ float bf2f(unsigned short h) { return __uint_as_float(((unsigned)h) << 16); }
__device__ __forceinline__ float bflo(unsigned w) { return __uint_as_float(w << 16); }
__device__ __forceinline__ float bfhi(unsigned w) { return __uint_as_float(w & 0xffff0000u); }
__device__ __forceinline__ float shfl_x(float v, int m, int lane) { return __builtin_bit_cast(float, __builtin_amdgcn_ds_bpermute((lane ^ m) << 2, __builtin_bit_cast(int, v))); }
__device__ __forceinline__ float wave_sum(float v, int lane) {
#pragma unroll
    for (int o = 1; o < 64; o <<= 1) v += shfl_x(v, o, lane);
    return v;
}
__device__ __forceinline__ float silu_f(float v) { return v * __builtin_amdgcn_rcpf(1.f + __builtin_amdgcn_exp2f(-v * LOG2E)); }


namespace pg8 {
#define PG8_LAS __attribute__((address_space(3)))
typedef unsigned short bf16_t;
typedef short bf16x8 __attribute__((ext_vector_type(8)));
typedef float f32x4 __attribute__((ext_vector_type(4)));
typedef unsigned u32x4 __attribute__((ext_vector_type(4)));
constexpr int BM = 256, BK = 64, HALF = 128, HTB = HALF * BK * 2  , STAGE_BYTES = 8 * HTB, NXCD = 8, WGM = 8;

__host__ __device__ __forceinline__ int lds_byte(int r, int c) { const int st = (r >> 4) * 2 + (c >> 5), rr = r & 15, cc = c & 31, ob = rr * 64 + cc * 2; return st * 1024 + (ob ^ (((ob >> 9) & 1) << 5)); }
__host__ __device__ __forceinline__ void stage_rc(int b, int& R, int& C) { const int st = b / 1024, sb = b % 1024, swz = sb ^ (((sb >> 9) & 1) << 5); R = (st >> 1) * 16 + swz / 64; C = (st & 1) * 32 + (swz % 64) / 2; }
__host__ __device__ __forceinline__ int perm32(int rho) { const int n = rho >> 4, i = rho & 15; return 8 * (i >> 2) + 4 * n + (i & 3); }

struct Unit { int pm, pn; };
struct Gemm { const bf16_t* A; const bf16_t* Bt; int M, N, K, lda; };

struct StaticOrder {
    int nM, nN, nwg, G, c, rep;
    __host__ __device__ void init(int M, int N, int G_, int c_, int rep_ = 1) { nM = M / BM; nN = N / BM; nwg = nM * nN; G = G_; c = c_; rep = rep_; }
    __host__ __device__ bool next(int i, Unit& u) const {
        const long L = (long)i * G + c; if (L >= (long)nwg * rep) return false;
        int wgid = (int)(L % nwg); { const int q = nwg / NXCD, r = nwg % NXCD, xcd = wgid % NXCD, off = wgid / NXCD; wgid = (xcd < r ? xcd * (q + 1) : r * (q + 1) + (xcd - r) * q) + off; }
        const int nig = WGM * nN, gid = wgid / nig, fm = gid * WGM, gsz = (nM - fm) < WGM ? (nM - fm) : WGM;
        u.pm = fm + ((wgid % nig) % gsz); u.pn = (wgid % nig) / gsz; return true;
    }
    __device__ __forceinline__ void a_ready(const Unit&) const {}
    __device__ __forceinline__ void done(const Unit&) const {}
};

__device__ __forceinline__ unsigned cvt_pk_bf16(float lo, float hi) { unsigned r; asm volatile("v_cvt_pk_bf16_f32 %0, %1, %2" : "=v"(r) : "v"(lo), "v"(hi)); return r; }
typedef float f32x2 __attribute__((ext_vector_type(2)));
__device__ __forceinline__ f32x2 gelu_pk(f32x2 v) {
    const f32x2 av = __builtin_elementwise_abs(v), d = av * 0.2316418882f + 1.0f;
    f32x2 t; t.x = __builtin_amdgcn_rcpf(d.x); t.y = __builtin_amdgcn_rcpf(d.y);
    f32x2 q = t * 0.5307027145f + (-0.7265760135f); q = q * t + 0.7107068705f; q = q * t + (-0.142248368f); q = q * t + 0.127414796f; q = q * t;
    const f32x2 s = (v * v) * (-0.72134752044f);
    f32x2 e; e.x = __builtin_amdgcn_exp2f(s.x); e.y = __builtin_amdgcn_exp2f(s.y);
    const f32x2 m = v * (q * e), r = v - m;
    f32x2 o; o.x = v.x < 0.f ? m.x : r.x; o.y = v.y < 0.f ? m.y : r.y; return o;
}

template <class Epi, class Sched, bool ALIGN_EPI = false, bool SP2 = false>
__device__ __forceinline__ void gemm_phase(PG8_LAS unsigned char* lds, const Gemm g, const Sched& S, const Epi& E, const int wave_s) {
    const int tid = opaque_tid(wave_s), wid = __builtin_amdgcn_readfirstlane(tid >> 6), lane = tid & 63, wr = wid >> 2, wc = wid & 3, fr = lane & 15, fq = lane >> 4;
    const int K = g.K, nt = K / BK;
    unsigned voffA[2], voffB[2];
#pragma unroll
    for (int i = 0; i < 2; ++i) { int R, C; stage_rc(tid * 16 + i * 8192, R, C); const int Rb = Epi::PERM ? ((R & ~31) + perm32(R & 31)) : R;
        voffA[i] = (unsigned)(R * g.lda + C) * 2u; voffB[i] = (unsigned)(Rb * K + C) * 2u; }
    const size_t kstep = (size_t)(BK * 2);
    const size_t hstepA = (size_t)HALF * g.lda * 2, hstepB = (size_t)HALF * K * 2;
    const size_t tstepA = 2 * hstepA, tstepB = 2 * hstepB;
    const unsigned ldsw = (unsigned)wid * 1024u;
    const int aoff = lds_byte(wr * 64 + fr, fq * 8), boff = lds_byte(wc * 32 + fr, fq * 8);
#define PG8_SA(b, h) (((b) * 2 + (h)) * HTB)
#define PG8_SB(b, h) ((4 + (b) * 2 + (h)) * HTB)
#define PG8_STAGE(bufoff, gbase, voff) do { _Pragma("unroll") for (int _i = 0; _i < 2; ++_i) \
        __builtin_amdgcn_global_load_lds((const unsigned*)((const char*)(gbase) + (voff)[_i]), (PG8_LAS unsigned*)(lds + (bufoff) + ldsw + _i * 8192), 16, 0, 0); } while (0)
#define PG8_LDA(dst, b, h) do { _Pragma("unroll") for (int m = 0; m < 4; ++m) _Pragma("unroll") for (int k = 0; k < 2; ++k) dst[m][k] = *(const PG8_LAS bf16x8*)(lds + PG8_SA(b, h) + aoff + m * 2048 + k * 1024); } while (0)
#define PG8_LDB(dst, b, h) do { _Pragma("unroll") for (int n = 0; n < 2; ++n) _Pragma("unroll") for (int k = 0; k < 2; ++k) dst[n][k] = *(const PG8_LAS bf16x8*)(lds + PG8_SB(b, h) + boff + n * 2048 + k * 1024); } while (0)
#define PG8_MMA(ai, bj, At, Bt) do { __builtin_amdgcn_s_setprio(1); _Pragma("unroll") for (int m = 0; m < 4; ++m) _Pragma("unroll") for (int n = 0; n < 2; ++n) _Pragma("unroll") for (int k = 0; k < 2; ++k) \
        acc[ai][bj][m][n] = __builtin_amdgcn_mfma_f32_16x16x32_bf16(Bt[n][k], At[m][k], acc[ai][bj][m][n], 0, 0, 0); __builtin_amdgcn_s_setprio(0); } while (0)
#define PG8_WAIT_V(n) asm volatile("s_waitcnt vmcnt(" #n ")" ::: "memory")
#define PG8_WAIT_L(n) asm volatile("s_waitcnt lgkmcnt(" #n ")" ::: "memory")
#define PG8_BAR __builtin_amdgcn_s_barrier()
#define PG8_SCHED __builtin_amdgcn_sched_barrier(0)
    Unit cur, nxt; int ui = 0;
    if (!S.next(0, cur)) return;
    if constexpr (Epi::KHOOK || Epi::PREF) E.prefetch(cur, 0, lds, opaque_tid(wave_s));
    f32x4 acc[2][2][4][2];
#pragma unroll
    for (int a = 0; a < 2; ++a)
#pragma unroll
        for (int b = 0; b < 2; ++b)
#pragma unroll
            for (int m = 0; m < 4; ++m)
#pragma unroll
                for (int n = 0; n < 2; ++n) acc[a][b][m][n] = (f32x4){0.f, 0.f, 0.f, 0.f};
    bf16x8 At[4][2], B0[2][2], B1[2][2];
    const char* cA = (const char*)g.A + (size_t)cur.pm * tstepA; const char* cB = (const char*)g.Bt + (size_t)cur.pn * tstepB;
    S.a_ready(cur);
    if constexpr (SP2) {
        PG8_STAGE(PG8_SB(0, 0), cB, voffB); PG8_STAGE(PG8_SB(0, 1), cB + hstepB, voffB); PG8_STAGE(PG8_SA(0, 0), cA, voffA); PG8_STAGE(PG8_SA(0, 1), cA + hstepA, voffA);
        if (wr == 1) PG8_BAR;
        PG8_WAIT_V(2); PG8_BAR;
        PG8_STAGE(PG8_SB(1, 0), cB + kstep, voffB); PG8_STAGE(PG8_SA(1, 0), cA + kstep, voffA); PG8_STAGE(PG8_SB(1, 1), cB + hstepB + kstep, voffB);
        PG8_WAIT_V(6); PG8_BAR;
    } else {
        PG8_STAGE(PG8_SB(0, 0), cB, voffB); PG8_STAGE(PG8_SA(0, 0), cA, voffA); PG8_STAGE(PG8_SB(0, 1), cB + hstepB, voffB); PG8_STAGE(PG8_SA(0, 1), cA + hstepA, voffA);
        if (wr == 1) PG8_BAR;
        PG8_WAIT_V(4); PG8_BAR;
        PG8_STAGE(PG8_SB(1, 0), cB + kstep, voffB); PG8_STAGE(PG8_SA(1, 0), cA + kstep, voffA); PG8_STAGE(PG8_SB(1, 1), cB + hstepB + kstep, voffB);
        PG8_WAIT_V(6); PG8_BAR;
    }
    for (;;) {
        const bool has_next = S.next(ui + 1, nxt);
        const char* nA = has_next ? (const char*)g.A + (size_t)nxt.pm * tstepA : cA; const char* nB = has_next ? (const char*)g.Bt + (size_t)nxt.pn * tstepB : cB;
        for (int t = 0; t < nt; t += 2) {
            if constexpr (Epi::KHOOK) { if (t == 6 || t == 12) { const int l3_ = opaque_tid(wave_s) & 63; E.khook(acc, t, wr, l3_ & 15, ui & 1, lds); } }
            const bool last = (t == nt - 2);
            const char* a1 = cA + (size_t)(t + 1) * kstep;
            const char* a2 = last ? nA : cA + (size_t)(t + 2) * kstep; const char* b2 = last ? nB : cB + (size_t)(t + 2) * kstep;
            const char* a3 = a2 + kstep; const char* b3 = b2 + kstep;
            if (last && has_next) S.a_ready(nxt);
            if constexpr (SP2) {
            PG8_LDB(B0, 0, 0); PG8_LDB(B1, 0, 1); PG8_SCHED; PG8_LDA(At, 0, 0); PG8_STAGE(PG8_SA(1, 1), a1 + hstepA, voffA);
            PG8_WAIT_V(8); PG8_WAIT_L(0); PG8_BAR; PG8_MMA(0, 0, At, B0); PG8_MMA(0, 1, At, B1); PG8_BAR; PG8_SCHED;
            PG8_LDA(At, 0, 1); PG8_STAGE(PG8_SB(0, 0), b2, voffB); PG8_STAGE(PG8_SB(0, 1), b2 + hstepB, voffB); PG8_STAGE(PG8_SA(0, 0), a2, voffA);
            PG8_WAIT_V(8); PG8_WAIT_L(0); PG8_BAR; PG8_MMA(1, 0, At, B0); PG8_MMA(1, 1, At, B1); PG8_BAR; PG8_SCHED;
            PG8_LDB(B0, 1, 0); PG8_LDB(B1, 1, 1); PG8_SCHED; PG8_LDA(At, 1, 0); PG8_STAGE(PG8_SA(0, 1), a2 + hstepA, voffA);
            PG8_WAIT_V(8); PG8_WAIT_L(0); PG8_BAR; PG8_MMA(0, 0, At, B0); PG8_MMA(0, 1, At, B1); PG8_BAR; PG8_SCHED;
            PG8_LDA(At, 1, 1); PG8_STAGE(PG8_SB(1, 0), b3, voffB); PG8_STAGE(PG8_SB(1, 1), b3 + hstepB, voffB); PG8_STAGE(PG8_SA(1, 0), a3, voffA);
            PG8_WAIT_V(8); PG8_WAIT_L(0); PG8_BAR; PG8_MMA(1, 0, At, B0); PG8_MMA(1, 1, At, B1); PG8_BAR; PG8_SCHED;
            } else {
            PG8_LDB(B0, 0, 0); PG8_SCHED; PG8_LDA(At, 0, 0); PG8_STAGE(PG8_SA(1, 1), a1 + hstepA, voffA);
            PG8_WAIT_L(8); PG8_BAR; PG8_WAIT_L(0); PG8_MMA(0, 0, At, B0); PG8_BAR; PG8_SCHED;
            PG8_LDB(B1, 0, 1); PG8_STAGE(PG8_SB(0, 0), b2, voffB);
            PG8_BAR; PG8_WAIT_L(0); PG8_MMA(0, 1, At, B1); PG8_BAR;
            PG8_LDA(At, 0, 1); PG8_STAGE(PG8_SA(0, 0), a2, voffA);
            PG8_BAR; PG8_WAIT_L(0); PG8_MMA(1, 0, At, B0); PG8_BAR; PG8_SCHED;
            PG8_STAGE(PG8_SB(0, 1), b2 + hstepB, voffB);
            PG8_WAIT_V(6); PG8_BAR; PG8_MMA(1, 1, At, B1); PG8_BAR;
            PG8_LDB(B0, 1, 0); PG8_SCHED; PG8_LDA(At, 1, 0); PG8_STAGE(PG8_SA(0, 1), a2 + hstepA, voffA);
            PG8_WAIT_L(8); PG8_BAR; PG8_WAIT_L(0); PG8_MMA(0, 0, At, B0); PG8_BAR; PG8_SCHED;
            PG8_LDB(B1, 1, 1); PG8_STAGE(PG8_SB(1, 0), b3, voffB);
            PG8_BAR; PG8_WAIT_L(0); PG8_MMA(0, 1, At, B1); PG8_BAR;
            PG8_LDA(At, 1, 1); PG8_STAGE(PG8_SA(1, 0), a3, voffA);
            PG8_BAR; PG8_WAIT_L(0); PG8_MMA(1, 0, At, B0); PG8_BAR; PG8_SCHED;
            PG8_STAGE(PG8_SB(1, 1), b3 + hstepB, voffB);
            PG8_WAIT_V(6); PG8_BAR; PG8_MMA(1, 1, At, B1); PG8_BAR;
            }
        }
        if constexpr (ALIGN_EPI) { if (wr == 0) PG8_BAR; }
        if constexpr (Epi::KHOOK || Epi::PREF) { if (has_next) E.prefetch(nxt, (ui + 1) & 1, lds, opaque_tid(wave_s)); }
        if constexpr (!Epi::AFTER_DRAIN) { const int l2_ = opaque_tid(wave_s) & 63;
            if constexpr (Epi::PREF) E(acc, cur, wr, wc, l2_ & 15, l2_ >> 4, ui & 1, lds); else E(acc, cur, wr, wc, l2_ & 15, l2_ >> 4);
            S.done(cur); }
        if (!has_next) break;
#pragma unroll
        for (int a = 0; a < 2; ++a)
#pragma unroll
            for (int b = 0; b < 2; ++b)
#pragma unroll
                for (int m = 0; m < 4; ++m)
#pragma unroll
                    for (int n = 0; n < 2; ++n) acc[a][b][m][n] = (f32x4){0.f, 0.f, 0.f, 0.f};
        cur = nxt; cA = nA; cB = nB; ++ui;
        if constexpr (ALIGN_EPI) { if (wr == 1) PG8_BAR; }
    }
    PG8_WAIT_V(0);
    if constexpr (!ALIGN_EPI) { if (wr == 0) PG8_BAR; }
    PG8_BAR;
    if constexpr (Epi::AFTER_DRAIN) { E.fused(acc, cur, wr, wc, fr, fq, lds, wid, lane); S.done(cur); }
#undef PG8_SA
#undef PG8_SB
#undef PG8_STAGE
#undef PG8_LDA
#undef PG8_LDB
#undef PG8_MMA
#undef PG8_WAIT_V
#undef PG8_WAIT_L
#undef PG8_BAR
#undef PG8_SCHED
}
}

namespace pg8 {
__device__ __forceinline__ f32x2 swiglu_pk(f32x2 g, f32x2 u) {
    const f32x2 t = g * (-LOG2E); f32x2 e; e.x = __builtin_amdgcn_exp2f(t.x); e.y = __builtin_amdgcn_exp2f(t.y);
    const f32x2 d = e + 1.0f; f32x2 r; r.x = __builtin_amdgcn_rcpf(d.x); r.y = __builtin_amdgcn_rcpf(d.y);
    return (g * r) * u;
}
typedef unsigned long long ssq_t;
constexpr float SSQ_FX = 16777216.0f, SSQ_IFX = 1.0f / 16777216.0f;
__device__ __forceinline__ void ssq_put(ssq_t* p, int row, float q, int fr, int fq) {
    const int lane = fr + 16 * fq;
    q += shfl_x(q, 16, lane); q += shfl_x(q, 32, lane);
    if (fq == 0) __hip_atomic_fetch_add(p + row, (ssq_t)(q * SSQ_FX), __ATOMIC_RELAXED, __HIP_MEMORY_SCOPE_AGENT);
}
__device__ __forceinline__ float ssq_val(ssq_t v) { return (float)v * SSQ_IFX; }
struct EpiIn {
    static constexpr bool PERM = true, AFTER_DRAIN = false, KHOOK = false, PREF = false;
    bf16_t* O; const float* ropA; const float* ropB; const ssq_t* ssqx; const float* shw; ssq_t* ssq_cq; ssq_t* ssq_ckv;
    __device__ __forceinline__ void operator()(const f32x4 (&acc)[2][2][4][2], const Unit& u, int wr, int wc, int fr, int fq) const {
        const int row0 = u.pm * BM + wr * 64 + fr; const int b = (u.pm * BM) >> 12;
        ssq_t sv[8]; float rsv[8];
#pragma unroll
        for (int i = 0; i < 8; ++i) sv[i] = ssqx[row0 + (i >> 2) * HALF + (i & 3) * 16];
#pragma unroll
        for (int i = 0; i < 8; ++i) rsv[i] = 1.0f / sqrtf(ssq_val(sv[i]) * (1.0f / DM) + EPS);
#pragma unroll
        for (int bj = 0; bj < 2; ++bj) {
            const int colw = u.pn * BM + bj * HALF + wc * 32, col0 = colw + 8 * fq;
            const int mode = colw < 512 ? 1 : (colw < 640 ? 0 : (colw < 672 ? 2 : (colw < 1536 ? 0 : 3)));
            const int stat = (colw >= PC_CQ && colw < PC_CKV) ? 1 : ((colw >= PC_CKV && colw < PC_CKV + 256) ? 2 : 0);
            const float sc = colw < 384 ? QS_A : 1.f;
            const f32x4 s0 = *(const f32x4*)(shw + (size_t)b * 7680 + col0), s1 = *(const f32x4*)(shw + (size_t)b * 7680 + col0 + 4);
#pragma unroll
            for (int ai = 0; ai < 2; ++ai)
#pragma unroll
                for (int m = 0; m < 4; ++m) {
                    const int row = row0 + ai * HALF + m * 16;
                    const float rs = rsv[ai * 4 + m];
                    f32x4 v0 = acc[ai][bj][m][0] * rs + s0, v1 = acc[ai][bj][m][1] * rs + s1;
                    if (mode == 1 || mode == 2) {
                        const float* tp = (mode == 1) ? (ropA + ((size_t)row * 32 + ((col0 & 63) >> 1)) * 2) : (ropB + ((size_t)row * 16 + ((col0 - PC_KR) >> 1)) * 2);
                        const f32x4 c0 = *(const f32x4*)tp, c1 = *(const f32x4*)(tp + 4);
                        f32x4 w0, w1;
                        w0[0] = v0[0] * c0[0] - v0[1] * c0[1]; w0[1] = v0[1] * c0[0] + v0[0] * c0[1];
                        w0[2] = v0[2] * c0[2] - v0[3] * c0[3]; w0[3] = v0[3] * c0[2] + v0[2] * c0[3];
                        w1[0] = v1[0] * c1[0] - v1[1] * c1[1]; w1[1] = v1[1] * c1[0] + v1[0] * c1[1];
                        w1[2] = v1[2] * c1[2] - v1[3] * c1[3]; w1[3] = v1[3] * c1[2] + v1[2] * c1[3];
                        v0 = w0 * sc; v1 = w1 * sc;
                    } else if (mode == 3) {
                        const f32x2 a = gelu_pk((f32x2){v0[0], v0[1]}), bb = gelu_pk((f32x2){v0[2], v0[3]}), c = gelu_pk((f32x2){v1[0], v1[1]}), d = gelu_pk((f32x2){v1[2], v1[3]});
                        v0 = (f32x4){a.x, a.y, bb.x, bb.y}; v1 = (f32x4){c.x, c.y, d.x, d.y};
                    }
                    if (stat) {
                        const float q = (v0[0] * v0[0] + v0[1] * v0[1]) + (v0[2] * v0[2] + v0[3] * v0[3]) + (v1[0] * v1[0] + v1[1] * v1[1]) + (v1[2] * v1[2] + v1[3] * v1[3]);
                        ssq_put(stat == 1 ? ssq_cq : ssq_ckv, row, q, fr, fq);
                    }
                    u32x4 w; w.x = cvt_pk_bf16(v0[0], v0[1]); w.y = cvt_pk_bf16(v0[2], v0[3]); w.z = cvt_pk_bf16(v1[0], v1[1]); w.w = cvt_pk_bf16(v1[2], v1[3]);
                    *(u32x4*)(O + (size_t)row * PJP + col0) = w;
                }
        }
    }
};
struct EpiUQ {
    static constexpr bool PERM = true, AFTER_DRAIN = false, KHOOK = false, PREF = false;
    bf16_t* O; const ssq_t* ssq; const float* ropB;
    __device__ __forceinline__ void operator()(const f32x4 (&acc)[2][2][4][2], const Unit& u, int wr, int wc, int fr, int fq) const {
        const int row0 = u.pm * BM + wr * 64 + fr;
        ssq_t sv[8]; float rsv[8];
#pragma unroll
        for (int i = 0; i < 8; ++i) sv[i] = ssq[row0 + (i >> 2) * HALF + (i & 3) * 16];
#pragma unroll
        for (int i = 0; i < 8; ++i) rsv[i] = QS_B / sqrtf(ssq_val(sv[i]) * (1.0f / 384.0f) + EPS);
#pragma unroll
        for (int ai = 0; ai < 2; ++ai)
#pragma unroll
            for (int m = 0; m < 4; ++m) {
                const int row = row0 + ai * HALF + m * 16;
                const float rs = rsv[ai * 4 + m];
#pragma unroll
                for (int bj = 0; bj < 2; ++bj) {
                    const int colw = u.pn * BM + bj * HALF + wc * 32, col0 = colw + 8 * fq;
                    const bool rope = (colw % 96) == 64 && colw < 576;
                    f32x4 v0 = acc[ai][bj][m][0] * rs, v1 = acc[ai][bj][m][1] * rs;
                    if (rope) {
                        const float* tp = ropB + ((size_t)row * 16 + ((col0 - colw) >> 1)) * 2;
                        const f32x4 c0 = *(const f32x4*)tp, c1 = *(const f32x4*)(tp + 4);
                        f32x4 w0, w1;
                        w0[0] = v0[0] * c0[0] - v0[1] * c0[1]; w0[1] = v0[1] * c0[0] + v0[0] * c0[1];
                        w0[2] = v0[2] * c0[2] - v0[3] * c0[3]; w0[3] = v0[3] * c0[2] + v0[2] * c0[3];
                        w1[0] = v1[0] * c1[0] - v1[1] * c1[1]; w1[1] = v1[1] * c1[0] + v1[0] * c1[1];
                        w1[2] = v1[2] * c1[2] - v1[3] * c1[3]; w1[3] = v1[3] * c1[2] + v1[2] * c1[3];
                        v0 = w0; v1 = w1;
                    }
                    u32x4 w; w.x = cvt_pk_bf16(v0[0], v0[1]); w.y = cvt_pk_bf16(v0[2], v0[3]); w.z = cvt_pk_bf16(v1[0], v1[1]); w.w = cvt_pk_bf16(v1[2], v1[3]);
                    *(u32x4*)(O + (size_t)row * QMP + col0) = w;
                }
            }
    }
};
struct EpiUKV {
    static constexpr bool PERM = true, AFTER_DRAIN = false, KHOOK = false, PREF = false;
    bf16_t* O; const ssq_t* ssq;
    __device__ __forceinline__ void operator()(const f32x4 (&acc)[2][2][4][2], const Unit& u, int wr, int wc, int fr, int fq) const {
        const int row0 = u.pm * BM + wr * 64 + fr;
        ssq_t sv[8]; float rsv[8];
#pragma unroll
        for (int i = 0; i < 8; ++i) sv[i] = ssq[row0 + (i >> 2) * HALF + (i & 3) * 16];
#pragma unroll
        for (int i = 0; i < 8; ++i) rsv[i] = 1.0f / sqrtf(ssq_val(sv[i]) * (1.0f / 256.0f) + EPS);
#pragma unroll
        for (int ai = 0; ai < 2; ++ai)
#pragma unroll
            for (int m = 0; m < 4; ++m) {
                const int row = row0 + ai * HALF + m * 16;
                const float rs = rsv[ai * 4 + m];
#pragma unroll
                for (int bj = 0; bj < 2; ++bj) {
                    const int col0 = u.pn * BM + bj * HALF + wc * 32 + 8 * fq;
                    const f32x4 v0 = acc[ai][bj][m][0] * rs, v1 = acc[ai][bj][m][1] * rs;
                    u32x4 w; w.x = cvt_pk_bf16(v0[0], v0[1]); w.y = cvt_pk_bf16(v0[2], v0[3]); w.z = cvt_pk_bf16(v1[0], v1[1]); w.w = cvt_pk_bf16(v1[2], v1[3]);
                    *(u32x4*)(O + (size_t)row * KVP + col0) = w;
                }
            }
    }
};
template <bool GN> struct EpiRes {
    static constexpr bool PERM = true, AFTER_DRAIN = false, KHOOK = GN, PREF = false;
    const bf16_t* base; bf16_t* out; const float* gate; bf16_t* xg; const float* nw; const float* sc; ssq_t* ssq; const ssq_t* gsa; const ssq_t* gsb; const ssq_t* gsc;
    __device__ __forceinline__ void prefetch(const Unit& u, int par, PG8_LAS unsigned char* lds, int tid) const {
        if (tid < BM) {
            const int row = u.pm * BM + tid;
            const float sa = ssq_val(gsa[row]) * (1.0f / 384.0f) + EPS, sb = ssq_val(gsb[row]) * (1.0f / 384.0f) + EPS, sc_ = ssq_val(gsc[row]) * (1.0f / 256.0f) + EPS;
            PG8_LAS float* rp = (PG8_LAS float*)(lds + STAGE_BYTES + 1024) + par * 512;
            rp[tid] = sqrtf(sb / sa); rp[256 + tid] = sqrtf(sc_ / sb);
        }
    }
    __device__ __forceinline__ void khook(f32x4 (&acc)[2][2][4][2], int t, int wr, int fr, int par, PG8_LAS unsigned char* lds) const {
        const PG8_LAS float* rp = (const PG8_LAS float*)(lds + STAGE_BYTES + 1024) + par * 512 + (t == 6 ? 0 : 256) + wr * 64 + fr;
#pragma unroll
        for (int i = 0; i < 8; ++i) {
            const float r = rp[(i >> 2) * HALF + (i & 3) * 16];
#pragma unroll
            for (int bj = 0; bj < 2; ++bj)
#pragma unroll
                for (int n = 0; n < 2; ++n) acc[i >> 2][bj][i & 3][n] *= r;
        }
    }
    __device__ __forceinline__ void operator()(const f32x4 (&acc)[2][2][4][2], const Unit& u, int wr, int wc, int fr, int fq) const {
        float rc[8];
        if constexpr (GN) { ssq_t sc_[8];
#pragma unroll
            for (int i = 0; i < 8; ++i) sc_[i] = gsc[u.pm * BM + wr * 64 + fr + (i >> 2) * HALF + (i & 3) * 16];
#pragma unroll
            for (int i = 0; i < 8; ++i) rc[i] = 1.0f / sqrtf(ssq_val(sc_[i]) * (1.0f / 256.0f) + EPS); }
        const int col0 = u.pn * BM + wc * 32 + 8 * fq; const int b = (u.pm * BM) >> 12;
        const float* gp = gate + (size_t)b * NMOD + col0; const float* sp = sc + (size_t)b * NMOD + col0;
        f32x4 g[2][2], cf[2][2];
#pragma unroll
        for (int bj = 0; bj < 2; ++bj) {
            g[bj][0] = *(const f32x4*)(gp + bj * HALF); g[bj][1] = *(const f32x4*)(gp + bj * HALF + 4);
            const f32x4 n0 = *(const f32x4*)(nw + col0 + bj * HALF), n1 = *(const f32x4*)(nw + col0 + bj * HALF + 4);
            const f32x4 c0 = *(const f32x4*)(sp + bj * HALF), c1 = *(const f32x4*)(sp + bj * HALF + 4);
            cf[bj][0] = n0 * (c0 + 1.0f); cf[bj][1] = n1 * (c1 + 1.0f);
        }
#pragma unroll
        for (int ai = 0; ai < 2; ++ai)
#pragma unroll
        for (int mp = 0; mp < 4; mp += 2) {
            u32x4 bv[2][2];
#pragma unroll
            for (int mm = 0; mm < 2; ++mm)
#pragma unroll
                for (int bj = 0; bj < 2; ++bj)
                    bv[mm][bj] = *(const u32x4*)(base + (size_t)(u.pm * BM + ai * HALF + wr * 64 + (mp + mm) * 16 + fr) * DM + col0 + bj * HALF);
#pragma unroll
            for (int mm = 0; mm < 2; ++mm) {
                const int m = mp + mm;
                const int row = u.pm * BM + ai * HALF + wr * 64 + m * 16 + fr; float q = 0.f;
#pragma unroll
                for (int bj = 0; bj < 2; ++bj) {
                    const size_t off = (size_t)row * DM + col0 + bj * HALF;
                    const u32x4 bw = bv[mm][bj];
                    const f32x4 b0 = (f32x4){__uint_as_float(bw.x << 16), __uint_as_float(bw.x & 0xffff0000u), __uint_as_float(bw.y << 16), __uint_as_float(bw.y & 0xffff0000u)};
                    const f32x4 b1 = (f32x4){__uint_as_float(bw.z << 16), __uint_as_float(bw.z & 0xffff0000u), __uint_as_float(bw.w << 16), __uint_as_float(bw.w & 0xffff0000u)};
                    f32x4 a0 = acc[ai][bj][m][0], a1 = acc[ai][bj][m][1]; if constexpr (GN) { a0 *= rc[ai * 4 + m]; a1 *= rc[ai * 4 + m]; }
                    const f32x4 o0 = b0 + g[bj][0] * a0, o1 = b1 + g[bj][1] * a1;
                    u32x4 wo; wo.x = cvt_pk_bf16(o0[0], o0[1]); wo.y = cvt_pk_bf16(o0[2], o0[3]); wo.z = cvt_pk_bf16(o1[0], o1[1]); wo.w = cvt_pk_bf16(o1[2], o1[3]);
                    *(u32x4*)(out + off) = wo;
                    if (xg) {
                        const f32x4 h0 = o0 * cf[bj][0], h1 = o1 * cf[bj][1];
                        u32x4 w; w.x = cvt_pk_bf16(h0[0], h0[1]); w.y = cvt_pk_bf16(h0[2], h0[3]); w.z = cvt_pk_bf16(h1[0], h1[1]); w.w = cvt_pk_bf16(h1[2], h1[3]);
                        *(u32x4*)(xg + off) = w;
                        q += (o0[0] * o0[0] + o0[1] * o0[1]) + (o0[2] * o0[2] + o0[3] * o0[3]) + (o1[0] * o1[0] + o1[1] * o1[1]) + (o1[2] * o1[2] + o1[3] * o1[3]);
                    }
                }
                if (xg) ssq_put(ssq, row, q, fr, fq);
            }
        }
    }
};
struct EpiGU {
    static constexpr bool PERM = true, AFTER_DRAIN = false, KHOOK = false, PREF = true;
    bf16_t* O; const ssq_t* ssqx; const float* shw;
    __device__ __forceinline__ void prefetch(const Unit& u, int par, PG8_LAS unsigned char* lds, int tid) const {
        PG8_LAS float* rp = (PG8_LAS float*)(lds + STAGE_BYTES + 5120) + par * 512;
        if (tid < BM) rp[tid] = 1.0f / sqrtf(ssq_val(ssqx[u.pm * BM + tid]) * (1.0f / DM) + EPS);
        else rp[tid] = shw[(size_t)((u.pm * BM) >> 12) * 7680 + u.pn * BM + (tid - BM)];
    }
    __device__ __forceinline__ void operator()(const f32x4 (&acc)[2][2][4][2], const Unit& u, int wr, int wc, int fr, int fq, int par, PG8_LAS unsigned char* lds) const {
        const int row0 = u.pm * BM + wr * 64 + fr, col0 = u.pn * HALF + wc * 32 + 8 * fq;
        const PG8_LAS float* rp = (const PG8_LAS float*)(lds + STAGE_BYTES + 5120) + par * 512;
        const PG8_LAS float* sp = rp + 256 + wc * 32 + 8 * fq;
        const f32x4 sg0 = *(const PG8_LAS f32x4*)sp, sg1 = *(const PG8_LAS f32x4*)(sp + 4), su0 = *(const PG8_LAS f32x4*)(sp + HALF), su1 = *(const PG8_LAS f32x4*)(sp + HALF + 4);
        float rsv[8];
#pragma unroll
        for (int i = 0; i < 8; ++i) rsv[i] = rp[(i >> 2) * HALF + wr * 64 + (i & 3) * 16 + fr];
#pragma unroll
        for (int ai = 0; ai < 2; ++ai)
#pragma unroll
            for (int m = 0; m < 4; ++m) {
                const int row = row0 + ai * HALF + m * 16;
                const float rs = rsv[ai * 4 + m];
                const f32x4 g0 = acc[ai][0][m][0] * rs + sg0, g1 = acc[ai][0][m][1] * rs + sg1, u0 = acc[ai][1][m][0] * rs + su0, u1 = acc[ai][1][m][1] * rs + su1;
                f32x4 h0, h1;
                { const f32x2 a = swiglu_pk((f32x2){g0[0], g0[1]}, (f32x2){u0[0], u0[1]}), b2 = swiglu_pk((f32x2){g0[2], g0[3]}, (f32x2){u0[2], u0[3]});
                  const f32x2 c = swiglu_pk((f32x2){g1[0], g1[1]}, (f32x2){u1[0], u1[1]}), d = swiglu_pk((f32x2){g1[2], g1[3]}, (f32x2){u1[2], u1[3]});
                  h0 = (f32x4){a.x, a.y, b2.x, b2.y}; h1 = (f32x4){c.x, c.y, d.x, d.y}; }
                u32x4 w; w.x = cvt_pk_bf16(h0[0], h0[1]); w.y = cvt_pk_bf16(h0[2], h0[3]); w.z = cvt_pk_bf16(h1[0], h1[1]); w.w = cvt_pk_bf16(h1[2], h1[3]);
                *(u32x4*)(O + (size_t)row * FFN + col0) = w;
            }
    }
};
}

constexpr int KSTR = 104, VSTR = 72, ABUF = 64 * KSTR * 2 + 64 * VSTR * 2;
__device__ __forceinline__ int crow(int r, int hi) { return (r & 3) + 8 * (r >> 2) + 4 * hi; }
typedef __attribute__((address_space(1))) const u32x4 g_u32x4;
typedef __attribute__((address_space(1))) const bf16x8 g_bf16x8;
typedef float f32x2_cv __attribute__((ext_vector_type(2))); typedef __bf16 bf16x2_cv __attribute__((ext_vector_type(2)));
__device__ __forceinline__ unsigned cvtpk_s(float lo, float hi) { f32x2_cv v = {lo, hi}; bf16x2_cv b = __builtin_convertvector(v, bf16x2_cv); return __builtin_bit_cast(unsigned, b); }
__device__ __forceinline__ float max3f(float a, float b, float c) { float r; asm("v_max3_f32 %0, %1, %2, %3" : "=v"(r) : "v"(a), "v"(b), "v"(c)); return r; }
constexpr float RESC_THR = 8.0f;
constexpr int ABUF2 = 2 * ABUF;
template <int NDS, int MODE>
__device__ __forceinline__ void attn_unit(LAS unsigned char* lds, const bf16_t* Q, int qp, const bf16_t* K, int kp, const bf16_t* KR, int krp, const bf16_t* V, int vp,
                                          bf16_t* O, int op, int q0, float m_init, float l_init, unsigned long long* gss  , const int wave_s) {
    const int tid = opaque_tid(wave_s), lane = tid & 63, wid = __builtin_amdgcn_readfirstlane(tid >> 6), r32 = lane & 31, hi = lane >> 5;
    const int qw0 = q0 + 32 * wid;
    if (wid < 4) __builtin_amdgcn_s_setprio(1); else __builtin_amdgcn_s_setprio(0);
    bf16x8 qr[NDS];
    { const bf16_t* qrow = Q + (size_t)(qw0 + r32) * qp + 8 * hi;
#pragma unroll
      for (int d0 = 0; d0 < NDS; ++d0) qr[d0] = *(g_bf16x8*)(qrow + 16 * d0); }
    const int tp0 = (MODE == 1) ? ((q0 >= 128 ? q0 - 128 : 0) >> 7) : 0, tp1 = (q0 + 256) >> 7;
    const int srow = tid >> 3, sch = tid & 7;
    const int vrow = lane, vch = wid;
    const int vpos = (vrow & ~12) | ((vrow & 4) << 1) | ((vrow & 8) >> 1);
    const unsigned koff = (unsigned)(srow * kp + 8 * sch) * 2u, voff = (unsigned)(vrow * vp + 8 * vch) * 2u, kroff = (unsigned)((tid >> 2) * krp + 8 * (tid & 3)) * 2u;
    const bool do_kr = (NDS == 6) && tid < 256;
    u32x4 kreg0, vreg0, krreg0 = (u32x4){0u, 0u, 0u, 0u}, kreg1, vreg1, krreg1 = (u32x4){0u, 0u, 0u, 0u};
#define AT_GLOAD(tp) do { const size_t ro_ = (size_t)(tp) * 128; \
        const char* kt_ = (const char*)(K + ro_ * kp); const char* vt2_ = (const char*)(V + ro_ * vp); \
        kreg0 = *(g_u32x4*)(kt_ + koff); kreg1 = *(g_u32x4*)(kt_ + (size_t)64 * kp * 2 + koff); vreg0 = *(g_u32x4*)(vt2_ + voff); vreg1 = *(g_u32x4*)(vt2_ + (size_t)64 * vp * 2 + voff); \
        if (do_kr) { const char* rt_ = (const char*)(KR + ro_ * krp); krreg0 = *(g_u32x4*)(rt_ + kroff); krreg1 = *(g_u32x4*)(rt_ + (size_t)64 * krp * 2 + kroff); } } while (0)
#define AT_LW1(boff, kreg, vreg, krreg) do { LAS unsigned char* kb_ = lds + (boff); LAS unsigned short* vt_ = (LAS unsigned short*)(kb_ + 64 * KSTR * 2); \
        *(LAS u32x4*)(kb_ + (srow * KSTR + 8 * sch) * 2) = kreg; \
        if (do_kr) *(LAS u32x4*)(kb_ + ((tid >> 2) * KSTR + 64 + 8 * (tid & 3)) * 2) = krreg; \
        vt_[(8 * vch + 0) * VSTR + vpos] = (unsigned short)(vreg.x & 0xffffu); vt_[(8 * vch + 1) * VSTR + vpos] = (unsigned short)(vreg.x >> 16); \
        vt_[(8 * vch + 2) * VSTR + vpos] = (unsigned short)(vreg.y & 0xffffu); vt_[(8 * vch + 3) * VSTR + vpos] = (unsigned short)(vreg.y >> 16); \
        vt_[(8 * vch + 4) * VSTR + vpos] = (unsigned short)(vreg.z & 0xffffu); vt_[(8 * vch + 5) * VSTR + vpos] = (unsigned short)(vreg.z >> 16); \
        vt_[(8 * vch + 6) * VSTR + vpos] = (unsigned short)(vreg.w & 0xffffu); vt_[(8 * vch + 7) * VSTR + vpos] = (unsigned short)(vreg.w >> 16); } while (0)
#define AT_LWRITE(buf) do { AT_LW1((buf) * ABUF2, kreg0, vreg0, krreg0); AT_LW1((buf) * ABUF2 + ABUF, kreg1, vreg1, krreg1); } while (0)
    f32x16 o0, o1;
#pragma unroll
    for (int r = 0; r < 16; ++r) { o0[r] = 0.f; o1[r] = 0.f; }
    float m_run = (MODE == 1) ? m_init : 0.f, l_run = l_init;
    bool first = (MODE == 0);
    f32x16 negm;
#pragma unroll
    for (int r = 0; r < 16; ++r) negm[r] = -m_run;
    AT_GLOAD(tp0); AT_LWRITE(0);
    __syncthreads();
    int buf = 0;
    for (int tp = tp0; tp < tp1; ++tp) {
        if (tp + 1 < tp1) AT_GLOAD(tp + 1);
#pragma unroll
        for (int h = 0; h < 2; ++h) {
        const int kv0 = (2 * tp + h) * 64;
        bool active, needmask;
        if (MODE == 0) { active = kv0 <= qw0 + 31; needmask = kv0 + 63 > qw0; }
        else { active = (kv0 <= qw0 + 31) && (kv0 + 63 >= qw0 - 127); needmask = !((kv0 + 63 <= qw0) && (kv0 >= qw0 + 31 - 127)); }
        if (active) {
            const LAS unsigned char* kb = lds + buf * ABUF2 + h * ABUF + (r32 * KSTR + 8 * hi) * 2;
            const LAS unsigned char* vb = lds + buf * ABUF2 + h * ABUF + 64 * KSTR * 2 + (r32 * VSTR + 8 * hi) * 2;
            f32x16 p0, p1;
            { bf16x8 ka_[NDS], kc_[NDS];
#pragma unroll
              for (int d0 = 0; d0 < NDS; ++d0) { ka_[d0] = *(const LAS bf16x8*)(kb + d0 * 32); kc_[d0] = *(const LAS bf16x8*)(kb + 32 * KSTR * 2 + d0 * 32); }
              __builtin_amdgcn_sched_barrier(0);
#pragma unroll
              for (int d0 = 0; d0 < NDS; ++d0) {
                if (d0 == 0) { p0 = __builtin_amdgcn_mfma_f32_32x32x16_bf16(ka_[0], qr[0], negm, 0, 0, 0); p1 = __builtin_amdgcn_mfma_f32_32x32x16_bf16(kc_[0], qr[0], negm, 0, 0, 0); }
                else { p0 = __builtin_amdgcn_mfma_f32_32x32x16_bf16(ka_[d0], qr[d0], p0, 0, 0, 0); p1 = __builtin_amdgcn_mfma_f32_32x32x16_bf16(kc_[d0], qr[d0], p1, 0, 0, 0); }
              } }
            bf16x8 vf_[8];
#pragma unroll
            for (int c = 0; c < 4; ++c) { vf_[2 * c] = *(const LAS bf16x8*)(vb + c * 32); vf_[2 * c + 1] = *(const LAS bf16x8*)(vb + 32 * VSTR * 2 + c * 32); }
            __builtin_amdgcn_sched_barrier(0);
            asm volatile("s_nop 15\n\ts_nop 7" : "+v"(p0), "+v"(p1));
            if (needmask) {
                const int qa = qw0 + r32;
#pragma unroll
                for (int r = 0; r < 16; ++r) {
                    const int kv = kv0 + crow(r, hi);
                    bool k0 = kv > qa, k1 = kv + 32 > qa;
                    if (MODE == 1) { k0 = k0 || (kv + 128 <= qa); k1 = k1 || (kv + 32 + 128 <= qa); }
                    if (k0) p0[r] = -1e30f;
                    if (k1) p1[r] = -1e30f;
                }
            }
            float mxa = max3f(p0[0], p0[1], p1[0]), mxb = max3f(p0[2], p0[3], p1[1]); mxa = max3f(mxa, p1[2], p1[3]);
#pragma unroll
            for (int r = 4; r < 16; r += 4) { mxa = max3f(mxa, p0[r], p0[r + 1]); mxb = max3f(mxb, p0[r + 2], p0[r + 3]); mxa = max3f(mxa, p1[r], p1[r + 1]); mxb = max3f(mxb, p1[r + 2], p1[r + 3]); }
            float mx = max3f(mxa, mxb, mxb);
            mx = max3f(mx, shfl_x(mx, 32, lane), mx);
            if (first || __builtin_amdgcn_ballot_w64(mx > RESC_THR) != 0ull) {
                const float dl = first ? mx : fmaxf(mx, 0.f);
                const float f = first ? 1.0f : __builtin_amdgcn_exp2f(-dl);
                m_run += dl; l_run *= f;
#pragma unroll
                for (int r = 0; r < 16; ++r) { p0[r] -= dl; p1[r] -= dl; o0[r] *= f; o1[r] *= f; negm[r] = -m_run; }
                first = false;
            }
            float ls0 = 0.f, ls1 = 0.f;
#define AT_Q(P, B, c) do { \
            _Pragma("unroll") for (int r = 0; r < 8; ++r) P[(B) + r] = __builtin_amdgcn_exp2f(P[(B) + r]); \
            ls0 += (P[(B)] + P[(B) + 1]) + (P[(B) + 2] + P[(B) + 3]); ls1 += (P[(B) + 4] + P[(B) + 5]) + (P[(B) + 6] + P[(B) + 7]); \
            u32x4 w_; w_.x = cvtpk_s(P[(B)], P[(B) + 1]); w_.y = cvtpk_s(P[(B) + 2], P[(B) + 3]); w_.z = cvtpk_s(P[(B) + 4], P[(B) + 5]); w_.w = cvtpk_s(P[(B) + 6], P[(B) + 7]); \
            const bf16x8 pf_ = __builtin_bit_cast(bf16x8, w_); \
            o0 = __builtin_amdgcn_mfma_f32_32x32x16_bf16(vf_[2 * (c)], pf_, o0, 0, 0, 0); o1 = __builtin_amdgcn_mfma_f32_32x32x16_bf16(vf_[2 * (c) + 1], pf_, o1, 0, 0, 0); } while (0)
            AT_Q(p0, 0, 0); AT_Q(p0, 8, 1); AT_Q(p1, 0, 2); AT_Q(p1, 8, 3);
#undef AT_Q
            l_run += ls0 + ls1;
#pragma unroll
            for (int i_ = 0; i_ < 4; ++i_) { __builtin_amdgcn_sched_group_barrier(0x002, 20, 0); __builtin_amdgcn_sched_group_barrier(0x008, 2, 0); }
        }
        }
        if (tp + 1 < tp1) AT_LWRITE(buf ^ 1);
        __syncthreads();
        buf ^= 1;
    }
#undef AT_GLOAD
#undef AT_LW1
#undef AT_LWRITE
    const float lt = l_run + shfl_x(l_run, 32, lane);
    const float inv = 1.0f / lt;
    bf16_t* orow = O + (size_t)(qw0 + r32) * op + 4 * hi;
#pragma unroll
    for (int rg = 0; rg < 4; ++rg) {
        u32x2 a, b;
        a.x = cvtpk(o0[4 * rg] * inv, o0[4 * rg + 1] * inv); a.y = cvtpk(o0[4 * rg + 2] * inv, o0[4 * rg + 3] * inv);
        b.x = cvtpk(o1[4 * rg] * inv, o1[4 * rg + 1] * inv); b.y = cvtpk(o1[4 * rg + 2] * inv, o1[4 * rg + 3] * inv);
        *(u32x2*)(orow + 8 * rg) = a; *(u32x2*)(orow + 32 + 8 * rg) = b;
    }
    { float q = 0.f;
#pragma unroll
      for (int r = 0; r < 16; ++r) { const float a = o0[r] * inv, b = o1[r] * inv; q += a * a + b * b; }
      q += shfl_x(q, 32, lane);
      if (hi == 0) __hip_atomic_fetch_add(gss + qw0 + r32, (unsigned long long)(q * 16777216.0f), __ATOMIC_RELAXED, __HIP_MEMORY_SCOPE_AGENT); }
    __builtin_amdgcn_s_setprio(0);
}

constexpr int SWK = 72, SWT = 2 * 64 * SWK * 2;
__device__ __forceinline__ void swa_unit3(LAS unsigned char* lds, const bf16_t* pb  , bf16_t* Yb  , int q0, int kvh,
                                          const float* sinks  , unsigned long long* gss, const int wave_s) {
    const int tid = opaque_tid(wave_s), lane = tid & 63, wid = __builtin_amdgcn_readfirstlane(tid >> 6), r32 = lane & 31, hi = lane >> 5;
    const int qw0 = q0 + 32 * wid;
    const int kstart = q0 >= 128 ? q0 - 128 : 0, ntile = (q0 + 256 - kstart) >> 6;
    if (wid < 4) __builtin_amdgcn_s_setprio(1); else __builtin_amdgcn_s_setprio(0);
    bf16x8 qr[3][4];
#pragma unroll
    for (int g = 0; g < 3; ++g) { const bf16_t* qrow = pb + (size_t)(qw0 + r32) * PJP + PC_AQ + 64 * (3 * kvh + g) + 8 * hi;
#pragma unroll
        for (int d0 = 0; d0 < 4; ++d0) qr[g][d0] = *(g_bf16x8*)(qrow + 16 * d0); }
    {
        const int srow = tid >> 3, sch = tid & 7, vrow = lane, vch = wid;
        const int vpos = (vrow & ~12) | ((vrow & 4) << 1) | ((vrow & 8) >> 1);
        const bf16_t* kg = pb + (size_t)(kstart + srow) * PJP + PC_AK + 64 * kvh + 8 * sch;
        const bf16_t* vg = pb + (size_t)(kstart + vrow) * PJP + PC_AV + 64 * kvh + 8 * vch;
        u32x4 kreg[6], vreg[6];
#pragma unroll
        for (int t = 0; t < 6; ++t) if (t < ntile) { kreg[t] = *(g_u32x4*)(kg + (size_t)t * 64 * PJP); vreg[t] = *(g_u32x4*)(vg + (size_t)t * 64 * PJP); }
#pragma unroll
        for (int t = 0; t < 6; ++t) if (t < ntile) {
            LAS unsigned char* kb_ = lds + t * SWT; LAS unsigned short* vt_ = (LAS unsigned short*)(kb_ + 64 * SWK * 2);
            *(LAS u32x4*)(kb_ + (srow * SWK + 8 * sch) * 2) = kreg[t];
            const u32x4 vr = vreg[t];
            vt_[(8 * vch + 0) * SWK + vpos] = (unsigned short)(vr.x & 0xffffu); vt_[(8 * vch + 1) * SWK + vpos] = (unsigned short)(vr.x >> 16);
            vt_[(8 * vch + 2) * SWK + vpos] = (unsigned short)(vr.y & 0xffffu); vt_[(8 * vch + 3) * SWK + vpos] = (unsigned short)(vr.y >> 16);
            vt_[(8 * vch + 4) * SWK + vpos] = (unsigned short)(vr.z & 0xffffu); vt_[(8 * vch + 5) * SWK + vpos] = (unsigned short)(vr.z >> 16);
            vt_[(8 * vch + 6) * SWK + vpos] = (unsigned short)(vr.w & 0xffffu); vt_[(8 * vch + 7) * SWK + vpos] = (unsigned short)(vr.w >> 16);
        }
    }
    __syncthreads();
#pragma unroll
    for (int g = 0; g < 3; ++g) {
        const int hq = 3 * kvh + g;
        float m_run = sinks[hq] * LOG2E, l_run = 0.5f;
        f32x16 o0, o1, negm;
#pragma unroll
        for (int r = 0; r < 16; ++r) { o0[r] = 0.f; o1[r] = 0.f; negm[r] = -m_run; }
#pragma unroll 1
        for (int t = 0; t < ntile; ++t) {
            const int kv0 = kstart + 64 * t;
            const bool active = (kv0 <= qw0 + 31) && (kv0 + 63 >= qw0 - 127);
            if (!active) continue;
            const bool needmask = !((kv0 + 63 <= qw0) && (kv0 >= qw0 + 31 - 127));
            const LAS unsigned char* kb = lds + t * SWT + (r32 * SWK + 8 * hi) * 2;
            const LAS unsigned char* vb = lds + t * SWT + 64 * SWK * 2 + (r32 * SWK + 8 * hi) * 2;
            f32x16 p0, p1;
            { bf16x8 ka_[4], kc_[4];
#pragma unroll
              for (int d0 = 0; d0 < 4; ++d0) { ka_[d0] = *(const LAS bf16x8*)(kb + d0 * 32); kc_[d0] = *(const LAS bf16x8*)(kb + 32 * SWK * 2 + d0 * 32); }
              __builtin_amdgcn_sched_barrier(0);
#pragma unroll
              for (int d0 = 0; d0 < 4; ++d0) {
                if (d0 == 0) { p0 = __builtin_amdgcn_mfma_f32_32x32x16_bf16(ka_[0], qr[g][0], negm, 0, 0, 0); p1 = __builtin_amdgcn_mfma_f32_32x32x16_bf16(kc_[0], qr[g][0], negm, 0, 0, 0); }
                else { p0 = __builtin_amdgcn_mfma_f32_32x32x16_bf16(ka_[d0], qr[g][d0], p0, 0, 0, 0); p1 = __builtin_amdgcn_mfma_f32_32x32x16_bf16(kc_[d0], qr[g][d0], p1, 0, 0, 0); }
              } }
            bf16x8 vf_[8];
#pragma unroll
            for (int c = 0; c < 4; ++c) { vf_[2 * c] = *(const LAS bf16x8*)(vb + c * 32); vf_[2 * c + 1] = *(const LAS bf16x8*)(vb + 32 * SWK * 2 + c * 32); }
            __builtin_amdgcn_sched_barrier(0);
            asm volatile("s_nop 15\n\ts_nop 7" : "+v"(p0), "+v"(p1));
            if (needmask) {
                const int qa = qw0 + r32;
#pragma unroll
                for (int r = 0; r < 16; ++r) {
                    const int kv = kv0 + crow(r, hi);
                    const bool k0 = (kv > qa) || (kv + 128 <= qa), k1 = (kv + 32 > qa) || (kv + 32 + 128 <= qa);
                    if (k0) p0[r] = -1e30f;
                    if (k1) p1[r] = -1e30f;
                }
            }
            float mxa = max3f(p0[0], p0[1], p1[0]), mxb = max3f(p0[2], p0[3], p1[1]); mxa = max3f(mxa, p1[2], p1[3]);
#pragma unroll
            for (int r = 4; r < 16; r += 4) { mxa = max3f(mxa, p0[r], p0[r + 1]); mxb = max3f(mxb, p0[r + 2], p0[r + 3]); mxa = max3f(mxa, p1[r], p1[r + 1]); mxb = max3f(mxb, p1[r + 2], p1[r + 3]); }
            float mx = max3f(mxa, mxb, mxb);
            mx = max3f(mx, shfl_x(mx, 32, lane), mx);
            if (__builtin_amdgcn_ballot_w64(mx > RESC_THR) != 0ull) {
                const float dl = fmaxf(mx, 0.f), f = __builtin_amdgcn_exp2f(-dl);
                m_run += dl; l_run *= f;
#pragma unroll
                for (int r = 0; r < 16; ++r) { p0[r] -= dl; p1[r] -= dl; o0[r] *= f; o1[r] *= f; negm[r] = -m_run; }
            }
            float ls0 = 0.f, ls1 = 0.f;
#define SW_Q(P, B, c) do { \
            _Pragma("unroll") for (int r = 0; r < 8; ++r) P[(B) + r] = __builtin_amdgcn_exp2f(P[(B) + r]); \
            ls0 += (P[(B)] + P[(B) + 1]) + (P[(B) + 2] + P[(B) + 3]); ls1 += (P[(B) + 4] + P[(B) + 5]) + (P[(B) + 6] + P[(B) + 7]); \
            u32x4 w_; w_.x = cvtpk_s(P[(B)], P[(B) + 1]); w_.y = cvtpk_s(P[(B) + 2], P[(B) + 3]); w_.z = cvtpk_s(P[(B) + 4], P[(B) + 5]); w_.w = cvtpk_s(P[(B) + 6], P[(B) + 7]); \
            const bf16x8 pf_ = __builtin_bit_cast(bf16x8, w_); \
            o0 = __builtin_amdgcn_mfma_f32_32x32x16_bf16(vf_[2 * (c)], pf_, o0, 0, 0, 0); o1 = __builtin_amdgcn_mfma_f32_32x32x16_bf16(vf_[2 * (c) + 1], pf_, o1, 0, 0, 0); } while (0)
            SW_Q(p0, 0, 0); SW_Q(p0, 8, 1); SW_Q(p1, 0, 2); SW_Q(p1, 8, 3);
#undef SW_Q
            l_run += ls0 + ls1;
        }
        const float lt = l_run + shfl_x(l_run, 32, lane);
        const float inv = 1.0f / lt;
        bf16_t* orow = Yb + (size_t)(qw0 + r32) * DM + 64 * hq + 4 * hi;
#pragma unroll
        for (int rg = 0; rg < 4; ++rg) {
            u32x2 a, b;
            a.x = cvtpk(o0[4 * rg] * inv, o0[4 * rg + 1] * inv); a.y = cvtpk(o0[4 * rg + 2] * inv, o0[4 * rg + 3] * inv);
            b.x = cvtpk(o1[4 * rg] * inv, o1[4 * rg + 1] * inv); b.y = cvtpk(o1[4 * rg + 2] * inv, o1[4 * rg + 3] * inv);
            *(u32x2*)(orow + 8 * rg) = a; *(u32x2*)(orow + 32 + 8 * rg) = b;
        }
        { float q = 0.f;
#pragma unroll
          for (int r = 0; r < 16; ++r) { const float a = o0[r] * inv, b = o1[r] * inv; q += a * a + b * b; }
          q += shfl_x(q, 32, lane);
          if (hi == 0) __hip_atomic_fetch_add(gss + qw0 + r32, (unsigned long long)(q * 16777216.0f), __ATOMIC_RELAXED, __HIP_MEMORY_SCOPE_AGENT); }
    }
    __builtin_amdgcn_s_setprio(0);
    __syncthreads();
}

constexpr int SSTR = 136;
__device__ __forceinline__ void sgu_unit(LAS unsigned char* lds, const bf16_t* proj, bf16_t* Y, const bf16_t* wsb  , const float* lnw, const float* lnb, const float* bs  , int row0, unsigned long long* gss, const int wave_s) {
    const int tid = opaque_tid(wave_s), lane = tid & 63, wid = __builtin_amdgcn_readfirstlane(tid >> 6), r32 = lane & 31, hi = lane >> 5;
    LAS unsigned short* vt = (LAS unsigned short*)lds;
    {
        const int s = tid >> 2, q = tid & 3;
        const u32x4* src = (const u32x4*)(proj + (size_t)(row0 + s) * PJP + PC_CV + 64 * q);
        float v[64]; float sum = 0.f;
#pragma unroll
        for (int i = 0; i < 8; ++i) { const u32x4 w = src[i];
            v[8 * i + 0] = bflo(w.x); v[8 * i + 1] = bfhi(w.x); v[8 * i + 2] = bflo(w.y); v[8 * i + 3] = bfhi(w.y);
            v[8 * i + 4] = bflo(w.z); v[8 * i + 5] = bfhi(w.z); v[8 * i + 6] = bflo(w.w); v[8 * i + 7] = bfhi(w.w); }
#pragma unroll
        for (int i = 0; i < 64; ++i) sum += v[i];
        sum += shfl_x(sum, 1, lane); sum += shfl_x(sum, 2, lane);
        const float mu = sum * (1.0f / 256.0f); float sq = 0.f;
#pragma unroll
        for (int i = 0; i < 64; ++i) { v[i] -= mu; sq += v[i] * v[i]; }
        sq += shfl_x(sq, 1, lane); sq += shfl_x(sq, 2, lane);
        const float rstd = 1.0f / sqrtf(sq * (1.0f / 256.0f) + EPS);
#pragma unroll
        for (int i = 0; i < 64; i += 2) {
            const int c = 64 * q + i;
            const float a = v[i] * rstd * lnw[c] + lnb[c], b = v[i + 1] * rstd * lnw[c + 1] + lnb[c + 1];
            const unsigned w = cvtpk(a, b);
            vt[c * SSTR + s] = (unsigned short)(w & 0xffffu); vt[(c + 1) * SSTR + s] = (unsigned short)(w >> 16);
        }
    }
    __syncthreads();
    const int g = wid >> 1, dh = wid & 1;
    const LAS unsigned char* ab = lds + ((64 * g + 32 * dh + r32) * SSTR + 8 * hi) * 2;
    const bf16_t* wg = wsb + (size_t)g * 128 * 128;
#pragma unroll 1
    for (int tt = 0; tt < 4; ++tt) {
        f32x16 acc;
#pragma unroll
        for (int r = 0; r < 16; ++r) acc[r] = 0.f;
        const bf16_t* wrow = wg + (size_t)(32 * tt + r32) * 128 + 8 * hi;
        const int nk = 2 * (tt + 1);
        bf16x8 wf[8];
#pragma unroll
        for (int k = 0; k < 8; ++k) if (k < nk) wf[k] = *(g_bf16x8*)(wrow + 16 * k);
#pragma unroll
        for (int k = 0; k < 8; ++k) if (k < nk) {
            const bf16x8 a = *(const LAS bf16x8*)(ab + k * 32);
            acc = __builtin_amdgcn_mfma_f32_32x32x16_bf16(a, wf[k], acc, 0, 0, 0);
        }
        const int t = 32 * tt + r32; const size_t row = (size_t)row0 + t;
        const float bias = bs[g * 128 + t];
        const int cb = 64 * g + 32 * dh + 4 * hi; float qs = 0.f;
        u32x2 uwv[4];
#pragma unroll
        for (int rg = 0; rg < 4; ++rg) uwv[rg] = *(const u32x2*)(proj + row * PJP + PC_CU + cb + 8 * rg);
#pragma unroll
        for (int rg = 0; rg < 4; ++rg) {
            const u32x2 uw = uwv[rg];
            const float y0 = bflo(uw.x) * (acc[4 * rg] + bias), y1 = bfhi(uw.x) * (acc[4 * rg + 1] + bias), y2 = bflo(uw.y) * (acc[4 * rg + 2] + bias), y3 = bfhi(uw.y) * (acc[4 * rg + 3] + bias);
            u32x2 o; o.x = cvtpk(y0, y1); o.y = cvtpk(y2, y3);
            *(u32x2*)(Y + row * DM + 768 + cb + 8 * rg) = o;
            qs += (y0 * y0 + y1 * y1) + (y2 * y2 + y3 * y3);
        }
        qs += shfl_x(qs, 32, lane);
        if (hi == 0) __hip_atomic_fetch_add(gss + row, (unsigned long long)(qs * 16777216.0f), __ATOMIC_RELAXED, __HIP_MEMORY_SCOPE_AGENT);
    }
    __syncthreads();
}

__device__ __forceinline__ void norm_mod_pass(const float* x, const float* nw, const float* sh, const float* sc, bf16_t* H, int vcu, int ngw, const int wave_s) {
    const int tid_ = opaque_tid(wave_s), lane = tid_ & 63, gw = vcu * NWAVES + (tid_ >> 6);
    f32x4 wv[4];
#pragma unroll
    for (int j = 0; j < 4; ++j) wv[j] = *(const f32x4*)(nw + 4 * lane + 256 * j);
    for (int m_ = gw; m_ < REP_PASS * MTOK; m_ += ngw) {
        const int m = m_ % MTOK; const int b = m >> 12;
        const f32x4* xr = (const f32x4*)(x + (size_t)m * DM) + lane;
        f32x4 v[4]; float s = 0.f;
#pragma unroll
        for (int j = 0; j < 4; ++j) { v[j] = xr[64 * j]; s += (v[j].x * v[j].x + v[j].y * v[j].y) + (v[j].z * v[j].z + v[j].w * v[j].w); }
        const float rstd = 1.0f / sqrtf(wave_sum(s, lane) * (1.0f / DM) + EPS);
        unsigned long long* o8 = (unsigned long long*)(H + (size_t)m * DM) + lane;
#pragma unroll
        for (int j = 0; j < 4; ++j) {
            const f32x4 scv = *(const f32x4*)(sc + (size_t)b * NMOD + 4 * lane + 256 * j), shv = *(const f32x4*)(sh + (size_t)b * NMOD + 4 * lane + 256 * j);
            const f32x4 h = v[j] * rstd * wv[j] * (scv + 1.0f) + shv;
            o8[64 * j] = (unsigned long long)cvtpk(h.x, h.y) | ((unsigned long long)cvtpk(h.z, h.w) << 32);
        }
    }
}
__device__ __forceinline__ void group_norm_pass(const bf16_t* Y, const float* gwt, bf16_t* H, int vcu, int ngw, const int wave_s) {
    const int tid_ = opaque_tid(wave_s), lane = tid_ & 63, gw = vcu * NWAVES + (tid_ >> 6);
    const int seg = lane < 24 ? 0 : (lane < 48 ? 1 : 2);
    float g[16];
#pragma unroll
    for (int i = 0; i < 16; ++i) g[i] = gwt[16 * lane + i];
    for (int m_ = gw; m_ < REP_PASS * MTOK; m_ += ngw) {
        const int m = m_ % MTOK; const u32x4* yr = (const u32x4*)(Y + (size_t)m * DM + 16 * lane);
        const u32x4 a = yr[0], b = yr[1];
        float v[16];
        v[0] = bflo(a.x); v[1] = bfhi(a.x); v[2] = bflo(a.y); v[3] = bfhi(a.y); v[4] = bflo(a.z); v[5] = bfhi(a.z); v[6] = bflo(a.w); v[7] = bfhi(a.w);
        v[8] = bflo(b.x); v[9] = bfhi(b.x); v[10] = bflo(b.y); v[11] = bfhi(b.y); v[12] = bflo(b.z); v[13] = bfhi(b.z); v[14] = bflo(b.w); v[15] = bfhi(b.w);
        float s = 0.f;
#pragma unroll
        for (int i = 0; i < 16; ++i) s += v[i] * v[i];
        const float s0 = wave_sum(seg == 0 ? s : 0.f, lane), s1 = wave_sum(seg == 1 ? s : 0.f, lane), s2 = wave_sum(seg == 2 ? s : 0.f, lane);
        const float rstd = seg == 0 ? 1.0f / sqrtf(s0 * (1.0f / 384.0f) + EPS) : (seg == 1 ? 1.0f / sqrtf(s1 * (1.0f / 384.0f) + EPS) : 1.0f / sqrtf(s2 * (1.0f / 256.0f) + EPS));
        u32x4 oa, ob;
        oa.x = cvtpk(v[0] * rstd * g[0], v[1] * rstd * g[1]); oa.y = cvtpk(v[2] * rstd * g[2], v[3] * rstd * g[3]);
        oa.z = cvtpk(v[4] * rstd * g[4], v[5] * rstd * g[5]); oa.w = cvtpk(v[6] * rstd * g[6], v[7] * rstd * g[7]);
        ob.x = cvtpk(v[8] * rstd * g[8], v[9] * rstd * g[9]); ob.y = cvtpk(v[10] * rstd * g[10], v[11] * rstd * g[11]);
        ob.z = cvtpk(v[12] * rstd * g[12], v[13] * rstd * g[13]); ob.w = cvtpk(v[14] * rstd * g[14], v[15] * rstd * g[15]);
        u32x4* orow = (u32x4*)(H + (size_t)m * DM + 16 * lane);
        orow[0] = oa; orow[1] = ob;
    }
}
__device__ __forceinline__ void final_norm_pass(const bf16_t* x16, float* out, const float* nw, int vcu, int ngw, const int wave_s) {
    const int tid_ = opaque_tid(wave_s), lane = tid_ & 63, gw = vcu * NWAVES + (tid_ >> 6);
    f32x4 wv[4];
#pragma unroll
    for (int j = 0; j < 4; ++j) wv[j] = *(const f32x4*)(nw + 16 * lane + 4 * j);
    for (int m0 = 4 * gw; m0 < MTOK; m0 += 4 * ngw) {
        u32x4 a[4], b[4];
#pragma unroll
        for (int i = 0; i < 4; ++i) { const u32x4* xr = (const u32x4*)(x16 + (size_t)(m0 + i) * DM + 16 * lane); a[i] = xr[0]; b[i] = xr[1]; }
#pragma unroll
        for (int i = 0; i < 4; ++i) {
            f32x4 v[4];
            v[0] = (f32x4){bflo(a[i].x), bfhi(a[i].x), bflo(a[i].y), bfhi(a[i].y)}; v[1] = (f32x4){bflo(a[i].z), bfhi(a[i].z), bflo(a[i].w), bfhi(a[i].w)};
            v[2] = (f32x4){bflo(b[i].x), bfhi(b[i].x), bflo(b[i].y), bfhi(b[i].y)}; v[3] = (f32x4){bflo(b[i].z), bfhi(b[i].z), bflo(b[i].w), bfhi(b[i].w)};
            float s = 0.f;
#pragma unroll
            for (int j = 0; j < 4; ++j) s += (v[j].x * v[j].x + v[j].y * v[j].y) + (v[j].z * v[j].z + v[j].w * v[j].w);
            const float rstd = 1.0f / sqrtf(wave_sum(s, lane) * (1.0f / DM) + EPS);
            f32x4* orow = (f32x4*)(out + (size_t)(m0 + i) * DM + 16 * lane);
#pragma unroll
            for (int j = 0; j < 4; ++j) orow[j] = v[j] * rstd * wv[j];
        }
    }
}
__device__ __forceinline__ void xg_pass(const float* x, const float* nw, const float* sc, bf16_t* XGp, bf16_t* X16p, unsigned long long* ssq, int vcu, int ngw, const int wave_s) {
    const int tid_ = opaque_tid(wave_s), lane = tid_ & 63, gw = vcu * NWAVES + (tid_ >> 6);
    f32x4 wv[4];
#pragma unroll
    for (int j = 0; j < 4; ++j) wv[j] = *(const f32x4*)(nw + 4 * lane + 256 * j);
    for (int m0 = 2 * gw; m0 < MTOK; m0 += 2 * ngw) {
        const int b = m0 >> 12;
        f32x4 v[2][4], scv[4];
#pragma unroll
        for (int i = 0; i < 2; ++i)
#pragma unroll
            for (int j = 0; j < 4; ++j) v[i][j] = ((const f32x4*)(x + (size_t)(m0 + i) * DM) + lane)[64 * j];
#pragma unroll
        for (int j = 0; j < 4; ++j) scv[j] = *(const f32x4*)(sc + (size_t)b * NMOD + 4 * lane + 256 * j);
#pragma unroll
        for (int i = 0; i < 2; ++i) {
            const int m = m0 + i; float s = 0.f;
#pragma unroll
            for (int j = 0; j < 4; ++j) s += (v[i][j].x * v[i][j].x + v[i][j].y * v[i][j].y) + (v[i][j].z * v[i][j].z + v[i][j].w * v[i][j].w);
            s = wave_sum(s, lane);
            if (lane == 0) ssq[m] = (unsigned long long)(s * 16777216.0f);
            unsigned long long* o8 = (unsigned long long*)(XGp + (size_t)m * DM) + lane;
            unsigned long long* x8 = (unsigned long long*)(X16p + (size_t)m * DM) + lane;
#pragma unroll
            for (int j = 0; j < 4; ++j) {
                const f32x4 h = v[i][j] * wv[j] * (scv[j] + 1.0f);
                o8[64 * j] = (unsigned long long)cvtpk(h.x, h.y) | ((unsigned long long)cvtpk(h.z, h.w) << 32);
                x8[64 * j] = (unsigned long long)cvtpk(v[i][j].x, v[i][j].y) | ((unsigned long long)cvtpk(v[i][j].z, v[i][j].w) << 32);
            }
        }
    }
}
__device__ __forceinline__ void shw_tasks(const float* modp, const bf16_t* win, const bf16_t* wgu, float* shw, int vcu, int ngw, const int wave_s) {
    const int tid_ = opaque_tid(wave_s), lane = tid_ & 63, gw = vcu * NWAVES + (tid_ >> 6), r32 = lane & 31, hi = lane >> 5;
    for (int task = gw; task < DEPTH * 240; task += ngw) {
        const int l = task / 240, n0 = 32 * (task % 240);
        const bf16_t* wrow = (n0 < PJ) ? (win + l * WIN_L + (size_t)(n0 + r32) * DM) : (wgu + l * WGU_L + (size_t)(n0 - PJ + r32) * DM);
        const float* shp = modp + ((size_t)l * 16 + (r32 & 15)) * NMOD + (n0 < PJ ? 0 : 3 * DM) + 8 * hi;
        f32x16 acc;
#pragma unroll
        for (int r = 0; r < 16; ++r) acc[r] = 0.f;
#pragma unroll 16
        for (int k = 0; k < 64; ++k) {
            const f32x4 a0 = *(const f32x4*)(shp + 16 * k), a1 = *(const f32x4*)(shp + 16 * k + 4);
            u32x4 aw; aw.x = cvtpk(a0.x, a0.y); aw.y = cvtpk(a0.z, a0.w); aw.z = cvtpk(a1.x, a1.y); aw.w = cvtpk(a1.z, a1.w);
            const bf16x8 bfr = *(const bf16x8*)(wrow + 16 * k + 8 * hi);
            acc = __builtin_amdgcn_mfma_f32_32x32x16_bf16(__builtin_bit_cast(bf16x8, aw), bfr, acc, 0, 0, 0);
        }
#pragma unroll
        for (int r = 0; r < 8; ++r) shw[((size_t)l * 16 + crow(r, hi)) * 7680 + n0 + r32] = acc[r];
    }
}

__device__ __forceinline__ int map_col(int mat, int n) {
    if (mat == 0) {
        if (n < 512) { const int hh = n >> 6, i = n & 63; return hh * 64 + (i >> 1) + 32 * (i & 1); }
        if (n < 640) return n;
        if (n < 672) { const int i = n - 640; return 1280 + (i >> 1) + 16 * (i & 1); }
        if (n < 768) return -1;
        if (n < 1152) return 640 + (n - 768);
        if (n < 1408) return 1024 + (n - 1152);
        if (n < 1536) return -1;
        if (n < 1792) return 1312 + (n - 1536);
        return 1568 + (n - 1792);
    } else if (mat == 1) {
        if (n >= 576) return -1;
        const int h = n / 96, i = n - 96 * h;
        if (i < 64) return 96 * h + i;
        const int ii = i - 64; return 96 * h + 64 + (ii >> 1) + 16 * (ii & 1);
    } else if (mat == 4) {
        const int pn = n >> 8, bj = (n >> 7) & 1, i = n & 127; return (bj ? FFN : 0) + 128 * pn + i;
    }
    return n;
}
__device__ __forceinline__ void transpose_item(const float* W, int K, int Nsrc, bf16_t* WT, int kb, int nb, int mat, const float* kscale, LAS float* scr, int lane) {
    const int k0 = 64 * kb, n0 = 32 * nb;
    const int scol = map_col(mat, n0 + (lane & 31));
    float tv[32];
#pragma unroll
    for (int i = 0; i < 32; ++i) { const int kk = 2 * i + (lane >> 5); tv[i] = scol >= 0 ? W[(size_t)(k0 + kk) * Nsrc + scol] : 0.f; }
#pragma unroll
    for (int i = 0; i < 32; ++i) { const int kk = 2 * i + (lane >> 5); float v = tv[i]; if (kscale) v *= kscale[k0 + kk]; scr[kk * 33 + (lane & 31)] = v; }
    asm volatile("s_waitcnt lgkmcnt(0)" ::: "memory");
    const int c = lane & 7;
#pragma unroll
    for (int j = 0; j < 4; ++j) { const int n = (lane >> 3) + 8 * j; const LAS float* s = scr + (8 * c) * 33 + n;
        u32x4 o; o.x = cvtpk(s[0 * 33], s[1 * 33]); o.y = cvtpk(s[2 * 33], s[3 * 33]); o.z = cvtpk(s[4 * 33], s[5 * 33]); o.w = cvtpk(s[6 * 33], s[7 * 33]);
        *(u32x4*)(WT + (size_t)(n0 + n) * K + k0 + 8 * c) = o; }
    asm volatile("s_waitcnt lgkmcnt(0)" ::: "memory");
}
__device__ __forceinline__ void sincos_rev(float angf, float& c, float& s) {
    double rev = (double)angf * 0.15915494309189535; rev -= floor(rev);
    const double q4 = rev * 4.0; const double qn = rint(q4); const float r = (float)((q4 - qn) * 1.5707963267948966);
    const int q = ((int)qn) & 3; const float r2 = r * r;
    const float sn = r * (1.0f + r2 * (-1.0f / 6.0f + r2 * (1.0f / 120.0f + r2 * (-1.0f / 5040.0f + r2 * (1.0f / 362880.0f)))));
    const float cs = 1.0f + r2 * (-0.5f + r2 * (1.0f / 24.0f + r2 * (-1.0f / 720.0f + r2 * (1.0f / 40320.0f))));
    c = (q == 0) ? cs : (q == 1) ? -sn : (q == 2) ? -cs : sn;
    s = (q == 0) ? sn : (q == 1) ? cs : (q == 2) ? -sn : -cs;
}

__device__ __forceinline__ void prologue(const Args& A, LAS unsigned char* lds, int vcu, int G, const int wave_s) {
    const int tid = opaque_tid(wave_s), lane = tid & 63, wid = __builtin_amdgcn_readfirstlane(tid >> 6);
    unsigned char* ws = A.ws;
    {
        LAS float* cact = (LAS float*)lds;
        LAS float* red = (LAS float*)(lds + 65536);
        const float* c = A.in[1];
        for (int idx = tid; idx < NBATCH * DM; idx += NTHR) { const int b = idx >> 10, k = idx & 1023; cact[k * 16 + b] = silu_f(c[idx]); }
        __syncthreads();
        float* mod = (float*)(ws + WS_MOD);
        for (int tsk = vcu; tsk < DEPTH * 96; tsk += G) {
            const int l = tsk / 96, cgp = tsk % 96, n = 64 * cgp + lane;
            const float* wp = A.in[3] + ((size_t)l * DM + (size_t)wid * 128) * NMOD + n;
            float acc[16];
#pragma unroll
            for (int b = 0; b < 16; ++b) acc[b] = 0.f;
#pragma unroll 16
            for (int kk = 0; kk < 128; ++kk) {
                const float w = wp[(size_t)kk * NMOD];
                const LAS f32x4* cp = (const LAS f32x4*)(cact + (wid * 128 + kk) * 16);
                const f32x4 c0 = cp[0], c1 = cp[1], c2 = cp[2], c3 = cp[3];
                acc[0] += c0.x * w; acc[1] += c0.y * w; acc[2] += c0.z * w; acc[3] += c0.w * w;
                acc[4] += c1.x * w; acc[5] += c1.y * w; acc[6] += c1.z * w; acc[7] += c1.w * w;
                acc[8] += c2.x * w; acc[9] += c2.y * w; acc[10] += c2.z * w; acc[11] += c2.w * w;
                acc[12] += c3.x * w; acc[13] += c3.y * w; acc[14] += c3.z * w; acc[15] += c3.w * w;
            }
#pragma unroll
            for (int b = 0; b < 16; ++b) red[(wid * 16 + b) * 64 + lane] = acc[b];
            __syncthreads();
            for (int o = tid; o < 1024; o += NTHR) { const int b = o >> 6, nn = o & 63; float s = A.in[4][(size_t)l * NMOD + 64 * cgp + nn];
#pragma unroll
                for (int k8 = 0; k8 < 8; ++k8) s += red[(k8 * 16 + b) * 64 + nn];
                mod[((size_t)l * 16 + b) * NMOD + 64 * cgp + nn] = s; }
            __syncthreads();
        }
        __syncthreads();
    }
    {
        LAS float* scr = (LAS float*)(lds + wid * 16384);
        const int gw = vcu * NWAVES + wid, ngw = G * NWAVES;
        constexpr int I_IN = 16 * 64, I_UQ = 6 * 24, I_UKV = 4 * 24, I_OUT = 16 * 32, I_GU = 16 * 176, I_DN = 44 * 32, I_L = I_IN + I_UQ + I_UKV + I_OUT + I_GU + I_DN;
        for (int it = gw; it < DEPTH * I_L; it += ngw) {
            const int l = it / I_L; int r = it - l * I_L;
            if (r < I_IN) { transpose_item(A.in[6] + (size_t)l * DM * INC, DM, INC, (bf16_t*)(ws + WS_WIN) + l * WIN_L, r / 64, r % 64, 0, nullptr, scr, lane); continue; } r -= I_IN;
            if (r < I_UQ) { transpose_item(A.in[9] + (size_t)l * 384 * 576, 384, 576, (bf16_t*)(ws + WS_WUQ) + l * WUQ_L, r / 24, r % 24, 1, A.in[8] + l * 384, scr, lane); continue; } r -= I_UQ;
            if (r < I_UKV) { transpose_item(A.in[11] + (size_t)l * 256 * 768, 256, 768, (bf16_t*)(ws + WS_WUKV) + l * WUKV_L, r / 24, r % 24, 2, A.in[10] + l * 256, scr, lane); continue; } r -= I_UKV;
            if (r < I_OUT) { transpose_item(A.in[17] + (size_t)l * DM * DM, DM, DM, (bf16_t*)(ws + WS_WOUT) + l * WOUT_L, r / 32, r % 32, 3, A.in[16] + l * DM, scr, lane); continue; } r -= I_OUT;
            if (r < I_GU) { transpose_item(A.in[19] + (size_t)l * DM * 2 * FFN, DM, 2 * FFN, (bf16_t*)(ws + WS_WGU) + l * WGU_L, r / 176, r % 176, 4, nullptr, scr, lane); continue; } r -= I_GU;
            transpose_item(A.in[20] + (size_t)l * FFN * DM, FFN, DM, (bf16_t*)(ws + WS_WDN) + l * WDN_L, r / 32, r % 32, 5, nullptr, scr, lane);
        }
    }
    {
        const int gt = vcu * NTHR + tid, ngt = G * NTHR;
        bf16_t* wsb = (bf16_t*)(ws + WS_WS);
        for (int i = gt; i < DEPTH * 4 * 128 * 128 / 2; i += ngt) { const int e = 2 * i, s = e & 127, t = (e >> 7) & 127; const float a = s <= t ? A.in[14][e] : 0.f, b = (s + 1) <= t ? A.in[14][e + 1] : 0.f;
            ((unsigned*)wsb)[i] = cvtpk(a, b); }
        unsigned long long* ssqz = (unsigned long long*)(ws + WS_SSQ);
        for (int i = gt; i < DEPTH * 8 * MTOK; i += ngt) ssqz[i] = 0ull;
        f32x2* ra = (f32x2*)(ws + WS_ROPA); f32x2* rb = (f32x2*)(ws + WS_ROPB);
        const int* pos = (const int*)A.in[2];
        for (int i0 = gt; i0 < MTOK * 48; i0 += 4 * ngt) {
            int pv[4];
#pragma unroll
            for (int j = 0; j < 4; ++j) { const int i = i0 + j * ngt; pv[j] = (i < MTOK * 48) ? pos[i / 48] : 0; }
#pragma unroll
            for (int j = 0; j < 4; ++j) { const int i = i0 + j * ngt; if (i < MTOK * 48) { const int tok = i / 48, e = i - tok * 48; const float angf = (float)pv[j] * A.inv[e]; float c, s; sincos_rev(angf, c, s);
                if (e < 32) ra[(size_t)tok * 32 + e] = (f32x2){c, s}; else rb[(size_t)tok * 16 + (e - 32)] = (f32x2){c, s}; } }
        }
    }
}

#define RLX_AGENT __ATOMIC_RELAXED, __HIP_MEMORY_SCOPE_AGENT
#define XB_TMO      128
#define XB_XCNT(j)  (256  + 64 * (j))
#define XB_XSUB(j)  (1280 + 64 * (j))
#define XB_XGEN(j)  (2304 + 64 * (j))
#define XB_TOP      3328
#define XB_TOPGEN   3392
#define XCD_BAR_WORDS 3456
#define XB_SPIN_CAP (1u << 18)

__device__ __forceinline__ unsigned xb_ld(unsigned* p)              { return __hip_atomic_load(p, __ATOMIC_RELAXED, __HIP_MEMORY_SCOPE_AGENT); }
__device__ __forceinline__ unsigned xb_add(unsigned* p, unsigned v) { return __hip_atomic_fetch_add(p, v, __ATOMIC_RELAXED, __HIP_MEMORY_SCOPE_AGENT); }
__device__ __forceinline__ unsigned xb_xcc_id() { return (unsigned)__builtin_amdgcn_s_getreg((3 << 11) | 20) & 0xFu; }
#define XB_SPIN(cond, bar) do { unsigned _sp = 0; while (cond) { __builtin_amdgcn_s_sleep(1); \
    if ((++_sp & 255u) == 0u) { if (xb_ld(&(bar)[XB_TMO])) break; if (_sp > XB_SPIN_CAP) { atomicAdd(&(bar)[XB_TMO], 1u); break; } } } } while (0)

struct XcdBarrier {
    unsigned* bar; unsigned x;
    volatile LAS unsigned* st;
};

__device__ __forceinline__ XcdBarrier xcd_barrier_post(unsigned* bar, volatile LAS unsigned* st) {
    XcdBarrier b; b.bar = bar; b.x = xb_xcc_id(); b.st = st;
    if (threadIdx.x == 0) (void)xb_add(&bar[XB_XCNT(b.x)], 1u);
    return b;
}
__device__ __forceinline__ void xcd_barrier_complete(unsigned* bar, unsigned x, unsigned& nloc, unsigned& nx) {
    const unsigned G = gridDim.x * gridDim.y * gridDim.z;
    unsigned sum, cnt, mine, sp = 0u;
    for (;;) {
        sum = 0u; cnt = 0u; mine = 0u;
#pragma unroll
        for (unsigned j = 0; j < 16; ++j) { const unsigned c = xb_ld(&bar[XB_XCNT(j)]); sum += c; cnt += (c > 0u) ? 1u : 0u; mine = (j == x) ? c : mine; }
        if (sum == G) break;
        __builtin_amdgcn_s_sleep(1);
        if ((++sp & 255u) == 0u) { if (xb_ld(&bar[XB_TMO])) break; if (sp > XB_SPIN_CAP) { atomicAdd(&bar[XB_TMO], 1u); break; } }
    }
    nloc = mine > 0u ? mine : 1u; nx = cnt > 0u ? cnt : 1u;
}

__device__ __forceinline__ void xcd_barrier(const XcdBarrier& b) {
    asm volatile("s_waitcnt vmcnt(0)" ::: "memory");
    __syncthreads();
    if (threadIdx.x == 0) {
        unsigned* bar = b.bar;
        __builtin_amdgcn_s_waitcnt(0);
        unsigned nloc = b.st[0], nx = b.st[1];
        if (nloc == 0u) { xcd_barrier_complete(bar, b.x, nloc, nx); b.st[0] = nloc; b.st[1] = nx; }
        const unsigned old = xb_add(&bar[XB_XSUB(b.x)], 1u);
        const unsigned gen = old / nloc;
        if (old + 1u == (gen + 1u) * nloc) {
            __builtin_amdgcn_fence(__ATOMIC_RELEASE, "agent");
            asm volatile("s_waitcnt vmcnt(0)" ::: "memory");
            const unsigned og = xb_add(&bar[XB_TOP], 1u);
            const unsigned tg = og / nx;
            if (og + 1u == (tg + 1u) * nx) xb_add(&bar[XB_TOPGEN], 1u);
            else XB_SPIN(xb_ld(&bar[XB_TOPGEN]) == tg, bar);
            __builtin_amdgcn_fence(__ATOMIC_ACQUIRE, "agent");
            xb_add(&bar[XB_XGEN(b.x)], 1u);
            asm volatile("s_waitcnt vmcnt(0)" ::: "memory");
        } else {
            XB_SPIN(xb_ld(&bar[XB_XGEN(b.x)]) == gen, bar);
            __builtin_amdgcn_fence(__ATOMIC_ACQUIRE, "agent");
            asm volatile("s_waitcnt vmcnt(0)" ::: "memory");
        }
    }
    __syncthreads();
}

__global__ void __launch_bounds__(NTHR, 2) fwd_kernel(Args A) {
    extern __shared__ __attribute__((aligned(16))) unsigned char lds_raw[];
    LAS unsigned char* lds = (LAS unsigned char*)lds_raw;
    cg::grid_group grid = cg::this_grid();
    const int wave_s = __builtin_amdgcn_readfirstlane((int)threadIdx.x >> 6);
    if (threadIdx.x < 32) ((LAS unsigned*)(lds + MISC_OFF))[threadIdx.x] = (threadIdx.x == 16) ? (unsigned)blockIdx.x : 0u;
    __syncthreads();
    (void)xcd_barrier_post((unsigned*)(A.ws + WS_CTL), (volatile LAS unsigned*)(lds + MISC_OFF) + 8);
#define OPQ_PTR(T, member) ({ unsigned long long p_; asm volatile("s_load_dwordx2 %0, %1, %2\n\ts_waitcnt lgkmcnt(0)" : "=s"(p_) : "s"(__builtin_amdgcn_kernarg_segment_ptr()), "i"((int)__builtin_offsetof(Args, member))); (T)p_; })
#define ws OPQ_PTR(unsigned char*, ws)
#define G ((int)gridDim.x)
#define bx ({ int b_; asm volatile("v_mov_b32 %0, %1\n\tds_read_b32 %0, %0\n\ts_waitcnt lgkmcnt(0)" : "=v"(b_) : "i"(MISC_OFF + 64)); __builtin_amdgcn_readfirstlane(b_); })
#define vcu ({ const int b_ = bx; (G % 8 == 0) ? (b_ % 8) * (G / 8) + b_ / 8 : b_; })
#define ngw (G * NWAVES)
#define H ((bf16_t*)(ws + WS_Y))
#define X16 ((bf16_t*)(ws + WS_H))
#define PROJ ((bf16_t*)(ws + WS_PROJ))
#define QM ((bf16_t*)(ws + WS_QM))
#define KVM ((bf16_t*)(ws + WS_KVM))
#define Y ((bf16_t*)(ws + WS_Y))
#define HID ((bf16_t*)(ws + WS_HID))
#define mod ((const float*)(ws + WS_MOD))
#define ropA ((const float*)(ws + WS_ROPA))
#define ropB ((const float*)(ws + WS_ROPB))
#define xres OPQ_PTR(float*, out)
#define XG ((bf16_t*)(ws + WS_XG))
#define SHW ((const float*)(ws + WS_SHW))
#define SSQ(l_, w_) ((pg8::ssq_t*)(ws + WS_SSQ) + ((size_t)(l_) * 8 + (w_)) * MTOK)
    int ph = 0;
#if MK_MULTI
#define PHASE_ON() (ph >= A.ph_lo && ph < A.ph_hi)
#define SEAM() do { if (ph >= A.ph_lo && ph + 1 < A.ph_hi) grid.sync(); ++ph; } while (0)
#else
#define PHASE_ON() (true)
#define SEAM() do { XcdBarrier xb_; xb_.bar = (unsigned*)(ws + WS_CTL); xb_.x = xb_xcc_id(); xb_.st = (volatile LAS unsigned*)(lds + MISC_OFF) + 8; xcd_barrier(xb_); } while (0)
#endif

    if (PHASE_ON() && EN_PRO) prologue(A, lds, vcu, G, wave_s);
    grid.sync();
    shw_tasks(mod, (const bf16_t*)(ws + WS_WIN), (const bf16_t*)(ws + WS_WGU), (float*)(ws + WS_SHW), vcu, ngw, wave_s);
    xg_pass(A.in[0], A.in[5], mod + 1 * DM, XG, X16, SSQ(0, 0), vcu, ngw, wave_s);
    SEAM();
#pragma unroll 1
    for (int l = 0; l < DEPTH; ++l) {
#define modl (mod + (size_t)l * 16 * NMOD)
#define xin ((l == 0) ? A.in[0] : (const float*)xres)
        if (PHASE_ON() && EN_P2) {
            pg8::Gemm g{XG, (const bf16_t*)(ws + WS_WIN) + l * WIN_L, MTOK, PJ, DM, DM}; pg8::StaticOrder S; S.init(MTOK, PJ, G, bx, REP_G2);
            pg8::EpiIn E{PROJ, ropA, ropB, SSQ(l, 0), SHW + (size_t)l * 16 * 7680, SSQ(l, 2), SSQ(l, 3)};
            pg8::gemm_phase<pg8::EpiIn, pg8::StaticOrder, true, true>(lds, g, S, E, wave_s);
        }
        SEAM();
        if (PHASE_ON()) {
            if (EN_P3A) { pg8::Gemm g{PROJ + PC_CQ, (const bf16_t*)(ws + WS_WUQ) + l * WUQ_L, MTOK, 768, 384, PJP}; pg8::StaticOrder S; S.init(MTOK, 768, G, bx, REP_G3);
              pg8::EpiUQ E{QM, SSQ(l, 2), ropB};
              pg8::gemm_phase<pg8::EpiUQ, pg8::StaticOrder, true, true>(lds, g, S, E, wave_s); }
            if (EN_P3B) { pg8::Gemm g{PROJ + PC_CKV, (const bf16_t*)(ws + WS_WUKV) + l * WUKV_L, MTOK, 768, 256, PJP}; pg8::StaticOrder S; S.init(MTOK, 768, G, bx, REP_G3);
              pg8::EpiUKV E{KVM, SSQ(l, 3)};
              pg8::gemm_phase<pg8::EpiUKV, pg8::StaticOrder, true, true>(lds, g, S, E, wave_s); }
            __syncthreads();
            if (EN_P3C) for (int u = vcu; u < NBATCH * 16 * 2; u += G) {
                const int kvh = u & 1, qb = (u >> 1) & 15, b = u >> 5;
                swa_unit3(lds, PROJ + (size_t)b * SEQ * PJP, Y + (size_t)b * SEQ * DM, qb * 256, kvh, A.in[7] + l * 6, SSQ(l, 4) + (size_t)b * SEQ, wave_s);
            }
            if (EN_P3D) for (int u_ = vcu; u_ < REP_SGU * NBATCH * 32; u_ += G) { const int u = u_ % (NBATCH * 32);
                sgu_unit(lds, PROJ, Y, (const bf16_t*)(ws + WS_WS) + l * WS_L, A.in[12] + l * 256, A.in[13] + l * 256, A.in[15] + l * 512, u * 128, SSQ(l, 6), wave_s); }
        }
        SEAM();
        if (PHASE_ON() && EN_P4) {
            for (int u_ = vcu; u_ < REP_P4 * NBATCH * 6 * 8; u_ += G) {
                const int u = u_ % (NBATCH * 6 * 8); const int s = u & 7, bh = u >> 3, b = bh / 6, h = bh % 6;
                const bf16_t* qb_ = QM + (size_t)b * SEQ * QMP + 96 * h;
                const bf16_t* kb_ = KVM + (size_t)b * SEQ * KVP + 128 * h;
                const bf16_t* kr_ = PROJ + (size_t)b * SEQ * PJP + PC_KR;
                bf16_t* ob_ = Y + (size_t)b * SEQ * DM + 384 + 64 * h;
                attn_unit<6, 0>(lds, qb_, QMP, kb_, KVP, kr_, PJP, kb_ + 64, KVP, ob_, DM, (15 - s) * 256, -1e30f, 0.f, (u_ >= NBATCH * 6 * 8 ? SSQ(l, 7) : SSQ(l, 5)) + (size_t)b * SEQ, wave_s);
                attn_unit<6, 0>(lds, qb_, QMP, kb_, KVP, kr_, PJP, kb_ + 64, KVP, ob_, DM, s * 256, -1e30f, 0.f, (u_ >= NBATCH * 6 * 8 ? SSQ(l, 7) : SSQ(l, 5)) + (size_t)b * SEQ, wave_s);
            }
        }
        SEAM();
        if (PHASE_ON() && EN_P6) {
            pg8::Gemm g{Y, (const bf16_t*)(ws + WS_WOUT) + l * WOUT_L, MTOK, DM, DM, DM}; pg8::StaticOrder S; S.init(MTOK, DM, G, bx);
#pragma unroll 1
            for (int rep_ = 0; rep_ < REP_P6; ++rep_) { const bool dmy = rep_ + 1 < REP_P6;
            pg8::EpiRes<true> E{X16, dmy ? PROJ : X16, modl + 2 * DM, dmy ? QM : XG, A.in[18] + l * DM, modl + 4 * DM, dmy ? (pg8::ssq_t*)(ws + 1008 * MiB) : SSQ(l, 1), SSQ(l, 4), SSQ(l, 5), SSQ(l, 6)};
            pg8::gemm_phase<pg8::EpiRes<true>, pg8::StaticOrder, true, true>(lds, g, S, E, wave_s); }
        }
        SEAM();
        if (PHASE_ON() && EN_P8) {
            pg8::Gemm g{XG, (const bf16_t*)(ws + WS_WGU) + l * WGU_L, MTOK, 2 * FFN, DM, DM}; pg8::StaticOrder S; S.init(MTOK, 2 * FFN, G, bx, REP_G8);
            pg8::EpiGU E{HID, SSQ(l, 1), SHW + (size_t)l * 16 * 7680 + PJ};
            pg8::gemm_phase<pg8::EpiGU, pg8::StaticOrder, true, true>(lds, g, S, E, wave_s);
        }
        SEAM();
        if (PHASE_ON() && EN_P9) {
            pg8::Gemm g{HID, (const bf16_t*)(ws + WS_WDN) + l * WDN_L, MTOK, DM, FFN, FFN}; pg8::StaticOrder S; S.init(MTOK, DM, G, bx);
            const int ln = (l + 1 < DEPTH) ? l + 1 : l;
#pragma unroll 1
            for (int rep_ = 0; rep_ < REP_P9; ++rep_) { const bool dmy = rep_ + 1 < REP_P9;
            pg8::EpiRes<false> E{X16, dmy ? Y : X16, modl + 5 * DM, (l + 1 < DEPTH) ? (dmy ? Y : XG) : (bf16_t*)nullptr, A.in[5] + ln * DM, mod + (size_t)ln * 16 * NMOD + 1 * DM, dmy ? SSQ(l, 7) : SSQ(ln, 0), nullptr, nullptr, nullptr};
            pg8::gemm_phase<pg8::EpiRes<false>, pg8::StaticOrder, true, true>(lds, g, S, E, wave_s); }
        }
        SEAM();
    }
    if (PHASE_ON() && EN_FIN) final_norm_pass(X16, xres, A.in[21], vcu, ngw, wave_s);
#undef PHASE_ON
#undef SEAM
#undef ws
#undef G
#undef bx
#undef vcu
#undef ngw
#undef H
#undef PROJ
#undef QM
#undef KVM
#undef Y
#undef HID
#undef mod
#undef ropA
#undef ropB
#undef xres
#undef modl
#undef xin
#undef X16
#undef XG
#undef SHW
#undef SSQ
}

extern "C" void kernel_launch(void* const* d_in, const int* in_sizes, int n_in, void* d_out, int out_size, void* d_ws, size_t ws_size, hipStream_t stream) {
    static int grid = 0;
    if (grid == 0) {
        if (n_in != 22 || out_size != MTOK * DM || ws_size < WS_END) { fprintf(stderr, "kernel_launch: unexpected shapes (n_in %d out %d ws %zu)\n", n_in, out_size, ws_size); grid = -1; return; }
        int dev = 0, cus = 0, per_cu = 0;
        hipGetDevice(&dev); hipDeviceGetAttribute(&cus, hipDeviceAttributeMultiprocessorCount, dev);
        if (hipFuncSetAttribute((const void*)fwd_kernel, hipFuncAttributeMaxDynamicSharedMemorySize, LDS_BYTES) != hipSuccess) { fprintf(stderr, "kernel_launch: hipFuncSetAttribute failed\n"); grid = -1; return; }
        if (hipOccupancyMaxActiveBlocksPerMultiprocessor(&per_cu, (const void*)fwd_kernel, NTHR, LDS_BYTES) != hipSuccess || per_cu < 1) { fprintf(stderr, "kernel_launch: occupancy query says %d\n", per_cu); per_cu = 1; }
        (void)hipGetLastError();
        grid = cus;
    }
    if (grid < 0) return;
    if (hipMemsetAsync((char*)d_ws + WS_CTL, 0, CTL_BYTES, stream) != hipSuccess) { fprintf(stderr, "kernel_launch: memset failed\n"); return; }
    Args a{};
    for (int i = 0; i < 22; ++i) a.in[i] = (const float*)d_in[i];
    a.out = (float*)d_out; a.ws = (unsigned char*)d_ws;
    for (int j = 0; j < 32; ++j) a.inv[j] = (float)(1.0 / pow(10000.0, (double)(2 * j) / 64.0));
    for (int j = 0; j < 16; ++j) a.inv[32 + j] = (float)(1.0 / pow(10000.0, (double)(2 * j) / 32.0));
#if MK_MULTI
    const int nph = 1 + DEPTH * 9 + 1;
    for (int p = 0; p < nph; ++p) { a.ph_lo = p; a.ph_hi = p + 1; hipLaunchKernelGGL(fwd_kernel, dim3(grid), dim3(NTHR), LDS_BYTES, stream, a); }
#else
    a.ph_lo = 0; a.ph_hi = 1 << 20;
    void* args[] = {&a};
    hipError_t e = hipLaunchCooperativeKernel((const void*)fwd_kernel, dim3(grid), dim3(NTHR), args, LDS_BYTES, stream);
    if (e != hipSuccess) fprintf(stderr, "cooperative launch failed: %s (grid %d)\n", hipGetErrorString(e), grid);
#endif
}
```

```cpp
#include <hip/hip_runtime.h>
#include <hip/hip_cooperative_groups.h>
#include <cstdio>
#include <cstdint>
#include <cmath>
namespace cg = cooperative_groups;
#ifndef EN_PRO
#define EN_PRO 1
#endif
#ifndef EN_P1
#define EN_P1 1
#endif
#ifndef EN_P2
#define EN_P2 1
#endif
#ifndef EN_P3A
#define EN_P3A 1
#endif
#ifndef EN_P3B
#define EN_P3B 1
#endif
#ifndef EN_P3C
#define EN_P3C 1
#endif
#ifndef EN_P3D
#define EN_P3D 1
#endif
#ifndef EN_P4
#define EN_P4 1
#endif
#ifndef EN_P5
#define EN_P5 1
#endif
#ifndef EN_P6
#define EN_P6 1
#endif
#ifndef EN_P7
#define EN_P7 1
#endif
#ifndef EN_P8
#define EN_P8 1
#endif
#ifndef EN_P9
#define EN_P9 1
#endif
#ifndef EN_FIN
#define EN_FIN 1
#endif
#ifndef REP_PASS
#define REP_PASS 1
#endif
#ifndef REP_SWA
#define REP_SWA 1
#endif
#ifndef REP_SGU
#define REP_SGU 1
#endif
#ifndef REP_G2
#define REP_G2 1
#endif
#ifndef REP_G3
#define REP_G3 1
#endif
#ifndef REP_G8
#define REP_G8 1
#endif
#ifndef REP_PRO
#define REP_PRO 1
#endif
#ifndef REP_SYNC
#define REP_SYNC 1
#endif
#ifndef REP_P9
#define REP_P9 1
#endif
#ifndef REP_P6
#define REP_P6 1
#endif
#ifndef REP_P4
#define REP_P4 1
#endif
#ifndef MK_MULTI
#define MK_MULTI 0
#endif

#define LAS __attribute__((address_space(3)))
typedef unsigned short bf16_t;
typedef short bf16x8 __attribute__((ext_vector_type(8)));
typedef float f32x4 __attribute__((ext_vector_type(4)));
typedef float f32x2 __attribute__((ext_vector_type(2)));
typedef float f32x16 __attribute__((ext_vector_type(16)));
typedef unsigned u32x4 __attribute__((ext_vector_type(4)));
typedef unsigned u32x2 __attribute__((ext_vector_type(2)));

constexpr int DM = 1024, NBATCH = 16, SEQ = 4096, DEPTH = 4, MTOK = NBATCH * SEQ;
constexpr int INC = 1824, PJ = 2048, FFN = 2816, NMOD = 6 * DM;
constexpr int PJP = PJ + 64;
constexpr int PC_AQ = 0, PC_AK = 384, PC_AV = 512, PC_KR = 640, PC_CQ = 768, PC_CKV = 1152, PC_CU = 1536, PC_CV = 1792;
constexpr int QMP = 768, KVP = 768;
constexpr float EPS = 1e-6f;
constexpr float LOG2E = 1.4426950408889634f;
constexpr float QS_A = 0.125f * LOG2E;
constexpr float QS_B = 0.10206207261596575f * LOG2E;
constexpr int NWAVES = 8, NTHR = 512;
constexpr int LDS_BYTES = 147456;

constexpr size_t MiB = 1u << 20;
constexpr size_t WS_WIN = 0, WS_WUQ = 16 * MiB, WS_WUKV = 19 * MiB, WS_WOUT = 21 * MiB, WS_WGU = 29 * MiB, WS_WDN = 73 * MiB, WS_WS = 95 * MiB;
constexpr size_t WS_MOD = 96 * MiB, WS_ROPA = 98 * MiB, WS_ROPB = 114 * MiB;
constexpr size_t WS_H = 128 * MiB, WS_PROJ = 256 * MiB, WS_QM = 520 * MiB, WS_KVM = 616 * MiB, WS_Y = 712 * MiB, WS_HID = 256 * MiB, WS_CTL = 840 * MiB, WS_SHW = 845 * MiB, WS_XG = 848 * MiB, WS_SSQ = 976 * MiB, WS_END = 1008 * MiB;
constexpr size_t CTL_BYTES = 65536;
constexpr int MISC_OFF = 131072 + 320;
constexpr size_t WIN_L = (size_t)PJ * DM, WUQ_L = (size_t)768 * 384, WUKV_L = (size_t)768 * 256, WOUT_L = (size_t)DM * DM, WGU_L = (size_t)2 * FFN * DM, WDN_L = (size_t)DM * FFN, WS_L = (size_t)4 * 128 * 128;

struct Args {
    const float* in[22];
    float* out; unsigned char* ws;
    float inv[48];
    int ph_lo, ph_hi;
};

__device__ __forceinline__ int opaque_tid(int wave_s) { int l; asm volatile("v_mbcnt_lo_u32_b32 %0, -1, 0\n\tv_mbcnt_hi_u32_b32 %0, -1, %0" : "=v"(l)); return (wave_s << 6) | l; }
__device__ __forceinline__ unsigned cvtpk(float lo, float hi) { unsigned r; asm volatile("v_cvt_pk_bf16_f32 %0, %1, %2" : "=v"(r) : "v"(lo), "v"(hi)); return r; }
__device__ __forceinline__ float bf2f(unsigned short h) { return __uint_as_float(((unsigned)h) << 16); }
__device__ __forceinline__ float bflo(unsigned w) { return __uint_as_float(w << 16); }
__device__ __forceinline__ float bfhi(unsigned w) { return __uint_as_float(w & 0xffff0000u); }
__device__ __forceinline__ float shfl_x(float v, int m, int lane) { return __builtin_bit_cast(float, __builtin_amdgcn_ds_bpermute((lane ^ m) << 2, __builtin_bit_cast(int, v))); }
__device__ __forceinline__ float wave_sum(float v, int lane) {
#pragma unroll
    for (int o = 1; o < 64; o <<= 1) v += shfl_x(v, o, lane);
    return v;
}
__device__ __forceinline__ float silu_f(float v) { return v * __builtin_amdgcn_rcpf(1.f + __builtin_amdgcn_exp2f(-v * LOG2E)); }


namespace pg8 {
#define PG8_LAS __attribute__((address_space(3)))
typedef unsigned short bf16_t;
typedef short bf16x8 __attribute__((ext_vector_type(8)));
typedef float f32x4 __attribute__((ext_vector_type(4)));
typedef unsigned u32x4 __attribute__((ext_vector_type(4)));
constexpr int BM = 256, BK = 64, HALF = 128, HTB = HALF * BK * 2  , STAGE_BYTES = 8 * HTB, NXCD = 8, WGM = 8;

__host__ __device__ __forceinline__ int lds_byte(int r, int c) { const int st = (r >> 4) * 2 + (c >> 5), rr = r & 15, cc = c & 31, ob = rr * 64 + cc * 2; return st * 1024 + (ob ^ (((ob >> 9) & 1) << 5)); }
__host__ __device__ __forceinline__ void stage_rc(int b, int& R, int& C) { const int st = b / 1024, sb = b % 1024, swz = sb ^ (((sb >> 9) & 1) << 5); R = (st >> 1) * 16 + swz / 64; C = (st & 1) * 32 + (swz % 64) / 2; }
__host__ __device__ __forceinline__ int perm32(int rho) { const int n = rho >> 4, i = rho & 15; return 8 * (i >> 2) + 4 * n + (i & 3); }

struct Unit { int pm, pn; };
struct Gemm { const bf16_t* A; const bf16_t* Bt; int M, N, K, lda; };

struct StaticOrder {
    int nM, nN, nwg, G, c, rep;
    __host__ __device__ void init(int M, int N, int G_, int c_, int rep_ = 1) { nM = M / BM; nN = N / BM; nwg = nM * nN; G = G_; c = c_; rep = rep_; }
    __host__ __device__ bool next(int i, Unit& u) const {
        const long L = (long)i * G + c; if (L >= (long)nwg * rep) return false;
        int wgid = (int)(L % nwg); { const int q = nwg / NXCD, r = nwg % NXCD, xcd = wgid % NXCD, off = wgid / NXCD; wgid = (xcd < r ? xcd * (q + 1) : r * (q + 1) + (xcd - r) * q) + off; }
        const int nig = WGM * nN, gid = wgid / nig, fm = gid * WGM, gsz = (nM - fm) < WGM ? (nM - fm) : WGM;
        u.pm = fm + ((wgid % nig) % gsz); u.pn = (wgid % nig) / gsz; return true;
    }
    __device__ __forceinline__ void a_ready(const Unit&) const {}
    __device__ __forceinline__ void done(const Unit&) const {}
};

__device__ __forceinline__ unsigned cvt_pk_bf16(float lo, float hi) { unsigned r; asm volatile("v_cvt_pk_bf16_f32 %0, %1, %2" : "=v"(r) : "v"(lo), "v"(hi)); return r; }
typedef float f32x2 __attribute__((ext_vector_type(2)));
__device__ __forceinline__ f32x2 gelu_pk(f32x2 v) {
    const f32x2 av = __builtin_elementwise_abs(v), d = av * 0.2316418882f + 1.0f;
    f32x2 t; t.x = __builtin_amdgcn_rcpf(d.x); t.y = __builtin_amdgcn_rcpf(d.y);
    f32x2 q = t * 0.5307027145f + (-0.7265760135f); q = q * t + 0.7107068705f; q = q * t + (-0.142248368f); q = q * t + 0.127414796f; q = q * t;
    const f32x2 s = (v * v) * (-0.72134752044f);
    f32x2 e; e.x = __builtin_amdgcn_exp2f(s.x); e.y = __builtin_amdgcn_exp2f(s.y);
    const f32x2 m = v * (q * e), r = v - m;
    f32x2 o; o.x = v.x < 0.f ? m.x : r.x; o.y = v.y < 0.f ? m.y : r.y; return o;
}

template <class Epi, class Sched, bool ALIGN_EPI = false, bool SP2 = false>
__device__ __forceinline__ void gemm_phase(PG8_LAS unsigned char* lds, const Gemm g, const Sched& S, const Epi& E, const int wave_s) {
    const int tid = opaque_tid(wave_s), wid = __builtin_amdgcn_readfirstlane(tid >> 6), lane = tid & 63, wr = wid >> 2, wc = wid & 3, fr = lane & 15, fq = lane >> 4;
    const int K = g.K, nt = K / BK;
    unsigned voffA[2], voffB[2];
#pragma unroll
    for (int i = 0; i < 2; ++i) { int R, C; stage_rc(tid * 16 + i * 8192, R, C); const int Rb = Epi::PERM ? ((R & ~31) + perm32(R & 31)) : R;
        voffA[i] = (unsigned)(R * g.lda + C) * 2u; voffB[i] = (unsigned)(Rb * K + C) * 2u; }
    const size_t kstep = (size_t)(BK * 2);
    const size_t hstepA = (size_t)HALF * g.lda * 2, hstepB = (size_t)HALF * K * 2;
    const size_t tstepA = 2 * hstepA, tstepB = 2 * hstepB;
    const unsigned ldsw = (unsigned)wid * 1024u;
    const int aoff = lds_byte(wr * 64 + fr, fq * 8), boff = lds_byte(wc * 32 + fr, fq * 8);
#define PG8_SA(b, h) (((b) * 2 + (h)) * HTB)
#define PG8_SB(b, h) ((4 + (b) * 2 + (h)) * HTB)
#define PG8_STAGE(bufoff, gbase, voff) do { _Pragma("unroll") for (int _i = 0; _i < 2; ++_i) \
        __builtin_amdgcn_global_load_lds((const unsigned*)((const char*)(gbase) + (voff)[_i]), (PG8_LAS unsigned*)(lds + (bufoff) + ldsw + _i * 8192), 16, 0, 0); } while (0)
#define PG8_LDA(dst, b, h) do { _Pragma("unroll") for (int m = 0; m < 4; ++m) _Pragma("unroll") for (int k = 0; k < 2; ++k) dst[m][k] = *(const PG8_LAS bf16x8*)(lds + PG8_SA(b, h) + aoff + m * 2048 + k * 1024); } while (0)
#define PG8_LDB(dst, b, h) do { _Pragma("unroll") for (int n = 0; n < 2; ++n) _Pragma("unroll") for (int k = 0; k < 2; ++k) dst[n][k] = *(const PG8_LAS bf16x8*)(lds + PG8_SB(b, h) + boff + n * 2048 + k * 1024); } while (0)
#define PG8_MMA(ai, bj, At, Bt) do { __builtin_amdgcn_s_setprio(1); _Pragma("unroll") for (int m = 0; m < 4; ++m) _Pragma("unroll") for (int n = 0; n < 2; ++n) _Pragma("unroll") for (int k = 0; k < 2; ++k) \
        acc[ai][bj][m][n] = __builtin_amdgcn_mfma_f32_16x16x32_bf16(Bt[n][k], At[m][k], acc[ai][bj][m][n], 0, 0, 0); __builtin_amdgcn_s_setprio(0); } while (0)
#define PG8_WAIT_V(n) asm volatile("s_waitcnt vmcnt(" #n ")" ::: "memory")
#define PG8_WAIT_L(n) asm volatile("s_waitcnt lgkmcnt(" #n ")" ::: "memory")
#define PG8_BAR __builtin_amdgcn_s_barrier()
#define PG8_SCHED __builtin_amdgcn_sched_barrier(0)
    Unit cur, nxt; int ui = 0;
    if (!S.next(0, cur)) return;
    if constexpr (Epi::KHOOK || Epi::PREF) E.prefetch(cur, 0, lds, opaque_tid(wave_s));
    f32x4 acc[2][2][4][2];
#pragma unroll
    for (int a = 0; a < 2; ++a)
#pragma unroll
        for (int b = 0; b < 2; ++b)
#pragma unroll
            for (int m = 0; m < 4; ++m)
#pragma unroll
                for (int n = 0; n < 2; ++n) acc[a][b][m][n] = (f32x4){0.f, 0.f, 0.f, 0.f};
    bf16x8 At[4][2], B0[2][2], B1[2][2];
    const char* cA = (const char*)g.A + (size_t)cur.pm * tstepA; const char* cB = (const char*)g.Bt + (size_t)cur.pn * tstepB;
    S.a_ready(cur);
    if constexpr (SP2) {
        PG8_STAGE(PG8_SB(0, 0), cB, voffB); PG8_STAGE(PG8_SB(0, 1), cB + hstepB, voffB); PG8_STAGE(PG8_SA(0, 0), cA, voffA); PG8_STAGE(PG8_SA(0, 1), cA + hstepA, voffA);
        if (wr == 1) PG8_BAR;
        PG8_WAIT_V(2); PG8_BAR;
        PG8_STAGE(PG8_SB(1, 0), cB + kstep, voffB); PG8_STAGE(PG8_SA(1, 0), cA + kstep, voffA); PG8_STAGE(PG8_SB(1, 1), cB + hstepB + kstep, voffB);
        PG8_WAIT_V(6); PG8_BAR;
    } else {
        PG8_STAGE(PG8_SB(0, 0), cB, voffB); PG8_STAGE(PG8_SA(0, 0), cA, voffA); PG8_STAGE(PG8_SB(0, 1), cB + hstepB, voffB); PG8_STAGE(PG8_SA(0, 1), cA + hstepA, voffA);
        if (wr == 1) PG8_BAR;
        PG8_WAIT_V(4); PG8_BAR;
        PG8_STAGE(PG8_SB(1, 0), cB + kstep, voffB); PG8_STAGE(PG8_SA(1, 0), cA + kstep, voffA); PG8_STAGE(PG8_SB(1, 1), cB + hstepB + kstep, voffB);
        PG8_WAIT_V(6); PG8_BAR;
    }
    for (;;) {
        const bool has_next = S.next(ui + 1, nxt);
        const char* nA = has_next ? (const char*)g.A + (size_t)nxt.pm * tstepA : cA; const char* nB = has_next ? (const char*)g.Bt + (size_t)nxt.pn * tstepB : cB;
        for (int t = 0; t < nt; t += 2) {
            if constexpr (Epi::KHOOK) { if (t == 6 || t == 12) { const int l3_ = opaque_tid(wave_s) & 63; E.khook(acc, t, wr, l3_ & 15, ui & 1, lds); } }
            const bool last = (t == nt - 2);
            const char* a1 = cA + (size_t)(t + 1) * kstep;
            const char* a2 = last ? nA : cA + (size_t)(t + 2) * kstep; const char* b2 = last ? nB : cB + (size_t)(t + 2) * kstep;
            const char* a3 = a2 + kstep; const char* b3 = b2 + kstep;
            if (last && has_next) S.a_ready(nxt);
            if constexpr (SP2) {
            PG8_LDB(B0, 0, 0); PG8_LDB(B1, 0, 1); PG8_SCHED; PG8_LDA(At, 0, 0); PG8_STAGE(PG8_SA(1, 1), a1 + hstepA, voffA);
            PG8_WAIT_V(8); PG8_WAIT_L(0); PG8_BAR; PG8_MMA(0, 0, At, B0); PG8_MMA(0, 1, At, B1); PG8_BAR; PG8_SCHED;
            PG8_LDA(At, 0, 1); PG8_STAGE(PG8_SB(0, 0), b2, voffB); PG8_STAGE(PG8_SB(0, 1), b2 + hstepB, voffB); PG8_STAGE(PG8_SA(0, 0), a2, voffA);
            PG8_WAIT_V(8); PG8_WAIT_L(0); PG8_BAR; PG8_MMA(1, 0, At, B0); PG8_MMA(1, 1, At, B1); PG8_BAR; PG8_SCHED;
            PG8_LDB(B0, 1, 0); PG8_LDB(B1, 1, 1); PG8_SCHED; PG8_LDA(At, 1, 0); PG8_STAGE(PG8_SA(0, 1), a2 + hstepA, voffA);
            PG8_WAIT_V(8); PG8_WAIT_L(0); PG8_BAR; PG8_MMA(0, 0, At, B0); PG8_MMA(0, 1, At, B1); PG8_BAR; PG8_SCHED;
            PG8_LDA(At, 1, 1); PG8_STAGE(PG8_SB(1, 0), b3, voffB); PG8_STAGE(PG8_SB(1, 1), b3 + hstepB, voffB); PG8_STAGE(PG8_SA(1, 0), a3, voffA);
            PG8_WAIT_V(8); PG8_WAIT_L(0); PG8_BAR; PG8_MMA(1, 0, At, B0); PG8_MMA(1, 1, At, B1); PG8_BAR; PG8_SCHED;
            } else {
            PG8_LDB(B0, 0, 0); PG8_SCHED; PG8_LDA(At, 0, 0); PG8_STAGE(PG8_SA(1, 1), a1 + hstepA, voffA);
            PG8_WAIT_L(8); PG8_BAR; PG8_WAIT_L(0); PG8_MMA(0, 0, At, B0); PG8_BAR; PG8_SCHED;
            PG8_LDB(B1, 0, 1); PG8_STAGE(PG8_SB(0, 0), b2, voffB);
            PG8_BAR; PG8_WAIT_L(0); PG8_MMA(0, 1, At, B1); PG8_BAR;
            PG8_LDA(At, 0, 1); PG8_STAGE(PG8_SA(0, 0), a2, voffA);
            PG8_BAR; PG8_WAIT_L(0); PG8_MMA(1, 0, At, B0); PG8_BAR; PG8_SCHED;
            PG8_STAGE(PG8_SB(0, 1), b2 + hstepB, voffB);
            PG8_WAIT_V(6); PG8_BAR; PG8_MMA(1, 1, At, B1); PG8_BAR;
            PG8_LDB(B0, 1, 0); PG8_SCHED; PG8_LDA(At, 1, 0); PG8_STAGE(PG8_SA(0, 1), a2 + hstepA, voffA);
            PG8_WAIT_L(8); PG8_BAR; PG8_WAIT_L(0); PG8_MMA(0, 0, At, B0); PG8_BAR; PG8_SCHED;
            PG8_LDB(B1, 1, 1); PG8_STAGE(PG8_SB(1, 0), b3, voffB);
            PG8_BAR; PG8_WAIT_L(0); PG8_MMA(0, 1, At, B1); PG8_BAR;
            PG8_LDA(At, 1, 1); PG8_STAGE(PG8_SA(1, 0), a3, voffA);
            PG8_BAR; PG8_WAIT_L(0); PG8_MMA(1, 0, At, B0); PG8_BAR; PG8_SCHED;
            PG8_STAGE(PG8_SB(1, 1), b3 + hstepB, voffB);
            PG8_WAIT_V(6); PG8_BAR; PG8_MMA(1, 1, At, B1); PG8_BAR;
            }
        }
        if constexpr (ALIGN_EPI) { if (wr == 0) PG8_BAR; }
        if constexpr (Epi::KHOOK || Epi::PREF) { if (has_next) E.prefetch(nxt, (ui + 1) & 1, lds, opaque_tid(wave_s)); }
        if constexpr (!Epi::AFTER_DRAIN) { const int l2_ = opaque_tid(wave_s) & 63;
            if constexpr (Epi::PREF) E(acc, cur, wr, wc, l2_ & 15, l2_ >> 4, ui & 1, lds); else E(acc, cur, wr, wc, l2_ & 15, l2_ >> 4);
            S.done(cur); }
        if (!has_next) break;
#pragma unroll
        for (int a = 0; a < 2; ++a)
#pragma unroll
            for (int b = 0; b < 2; ++b)
#pragma unroll
                for (int m = 0; m < 4; ++m)
#pragma unroll
                    for (int n = 0; n < 2; ++n) acc[a][b][m][n] = (f32x4){0.f, 0.f, 0.f, 0.f};
        cur = nxt; cA = nA; cB = nB; ++ui;
        if constexpr (ALIGN_EPI) { if (wr == 1) PG8_BAR; }
    }
    PG8_WAIT_V(0);
    if constexpr (!ALIGN_EPI) { if (wr == 0) PG8_BAR; }
    PG8_BAR;
    if constexpr (Epi::AFTER_DRAIN) { E.fused(acc, cur, wr, wc, fr, fq, lds, wid, lane); S.done(cur); }
#undef PG8_SA
#undef PG8_SB
#undef PG8_STAGE
#undef PG8_LDA
#undef PG8_LDB
#undef PG8_MMA
#undef PG8_WAIT_V
#undef PG8_WAIT_L
#undef PG8_BAR
#undef PG8_SCHED
}
}

namespace pg8 {
__device__ __forceinline__ f32x2 swiglu_pk(f32x2 g, f32x2 u) {
    const f32x2 t = g * (-LOG2E); f32x2 e; e.x = __builtin_amdgcn_exp2f(t.x); e.y = __builtin_amdgcn_exp2f(t.y);
    const f32x2 d = e + 1.0f; f32x2 r; r.x = __builtin_amdgcn_rcpf(d.x); r.y = __builtin_amdgcn_rcpf(d.y);
    return (g * r) * u;
}
typedef unsigned long long ssq_t;
typedef __attribute__((address_space(1))) u32x4 gs_u32x4;
typedef __attribute__((address_space(1))) const u32x4 gl_u32x4;
#define PG8_GPTR(p) ((__attribute__((address_space(1))) char*)(p))
#define PG8_GCPTR(p) ((__attribute__((address_space(1))) const char*)(p))
constexpr float SSQ_FX = 16777216.0f, SSQ_IFX = 1.0f / 16777216.0f;
__device__ __forceinline__ void ssq_put(ssq_t* p, int row, float q, int fr, int fq) {
    const int lane = fr + 16 * fq;
    q += shfl_x(q, 16, lane); q += shfl_x(q, 32, lane);
    if (fq == 0) __hip_atomic_fetch_add(p + row, (ssq_t)(q * SSQ_FX), __ATOMIC_RELAXED, __HIP_MEMORY_SCOPE_AGENT);
}
__device__ __forceinline__ float ssq_val(ssq_t v) { return (float)v * SSQ_IFX; }
struct EpiIn {
    static constexpr bool PERM = true, AFTER_DRAIN = false, KHOOK = false, PREF = false;
    bf16_t* O; const float* ropA; const float* ropB; const ssq_t* ssqx; const float* shw; ssq_t* ssq_cq; ssq_t* ssq_ckv;
    __device__ __forceinline__ void operator()(const f32x4 (&acc)[2][2][4][2], const Unit& u, int wr, int wc, int fr, int fq) const {
        const int row0 = u.pm * BM + wr * 64 + fr; const int b = (u.pm * BM) >> 12;
        ssq_t sv[8]; float rsv[8];
#pragma unroll
        for (int i = 0; i < 8; ++i) sv[i] = ssqx[row0 + (i >> 2) * HALF + (i & 3) * 16];
#pragma unroll
        for (int i = 0; i < 8; ++i) rsv[i] = 1.0f / sqrtf(ssq_val(sv[i]) * (1.0f / DM) + EPS);
#pragma unroll
        for (int bj = 0; bj < 2; ++bj) {
            const int colw = u.pn * BM + bj * HALF + wc * 32, col0 = colw + 8 * fq;
            const int mode = colw < 512 ? 1 : (colw < 640 ? 0 : (colw < 672 ? 2 : (colw < 1536 ? 0 : 3)));
            const int stat = (colw >= PC_CQ && colw < PC_CKV) ? 1 : ((colw >= PC_CKV && colw < PC_CKV + 256) ? 2 : 0);
            const float sc = colw < 384 ? QS_A : 1.f;
            const f32x4 s0 = *(const f32x4*)(shw + (size_t)b * 7680 + col0), s1 = *(const f32x4*)(shw + (size_t)b * 7680 + col0 + 4);
#pragma unroll
            for (int ai = 0; ai < 2; ++ai)
#pragma unroll
                for (int m = 0; m < 4; ++m) {
                    const int row = row0 + ai * HALF + m * 16;
                    const float rs = rsv[ai * 4 + m];
                    f32x4 v0 = acc[ai][bj][m][0] * rs + s0, v1 = acc[ai][bj][m][1] * rs + s1;
                    if (mode == 1 || mode == 2) {
                        const float* tp = (mode == 1) ? (ropA + ((size_t)row * 32 + ((col0 & 63) >> 1)) * 2) : (ropB + ((size_t)row * 16 + ((col0 - PC_KR) >> 1)) * 2);
                        const f32x4 c0 = *(const f32x4*)tp, c1 = *(const f32x4*)(tp + 4);
                        f32x4 w0, w1;
                        w0[0] = v0[0] * c0[0] - v0[1] * c0[1]; w0[1] = v0[1] * c0[0] + v0[0] * c0[1];
                        w0[2] = v0[2] * c0[2] - v0[3] * c0[3]; w0[3] = v0[3] * c0[2] + v0[2] * c0[3];
                        w1[0] = v1[0] * c1[0] - v1[1] * c1[1]; w1[1] = v1[1] * c1[0] + v1[0] * c1[1];
                        w1[2] = v1[2] * c1[2] - v1[3] * c1[3]; w1[3] = v1[3] * c1[2] + v1[2] * c1[3];
                        v0 = w0 * sc; v1 = w1 * sc;
                    } else if (mode == 3) {
                        const f32x2 a = gelu_pk((f32x2){v0[0], v0[1]}), bb = gelu_pk((f32x2){v0[2], v0[3]}), c = gelu_pk((f32x2){v1[0], v1[1]}), d = gelu_pk((f32x2){v1[2], v1[3]});
                        v0 = (f32x4){a.x, a.y, bb.x, bb.y}; v1 = (f32x4){c.x, c.y, d.x, d.y};
                    }
                    if (stat) {
                        const float q = (v0[0] * v0[0] + v0[1] * v0[1]) + (v0[2] * v0[2] + v0[3] * v0[3]) + (v1[0] * v1[0] + v1[1] * v1[1]) + (v1[2] * v1[2] + v1[3] * v1[3]);
                        ssq_put(stat == 1 ? ssq_cq : ssq_ckv, row, q, fr, fq);
                    }
                    u32x4 w; w.x = cvt_pk_bf16(v0[0], v0[1]); w.y = cvt_pk_bf16(v0[2], v0[3]); w.z = cvt_pk_bf16(v1[0], v1[1]); w.w = cvt_pk_bf16(v1[2], v1[3]);
                    *(gs_u32x4*)(PG8_GPTR(O) + (unsigned)(row * PJP + col0) * 2u) = w;
                }
        }
    }
};
struct EpiUQ {
    static constexpr bool PERM = true, AFTER_DRAIN = false, KHOOK = false, PREF = false;
    bf16_t* O; const ssq_t* ssq; const float* ropB;
    __device__ __forceinline__ void operator()(const f32x4 (&acc)[2][2][4][2], const Unit& u, int wr, int wc, int fr, int fq) const {
        const int row0 = u.pm * BM + wr * 64 + fr;
        ssq_t sv[8]; float rsv[8];
#pragma unroll
        for (int i = 0; i < 8; ++i) sv[i] = ssq[row0 + (i >> 2) * HALF + (i & 3) * 16];
#pragma unroll
        for (int i = 0; i < 8; ++i) rsv[i] = QS_B / sqrtf(ssq_val(sv[i]) * (1.0f / 384.0f) + EPS);
#pragma unroll
        for (int ai = 0; ai < 2; ++ai)
#pragma unroll
            for (int m = 0; m < 4; ++m) {
                const int row = row0 + ai * HALF + m * 16;
                const float rs = rsv[ai * 4 + m];
#pragma unroll
                for (int bj = 0; bj < 2; ++bj) {
                    const int colw = u.pn * BM + bj * HALF + wc * 32, col0 = colw + 8 * fq;
                    const bool rope = (colw % 96) == 64 && colw < 576;
                    f32x4 v0 = acc[ai][bj][m][0] * rs, v1 = acc[ai][bj][m][1] * rs;
                    if (rope) {
                        const float* tp = ropB + ((size_t)row * 16 + ((col0 - colw) >> 1)) * 2;
                        const f32x4 c0 = *(const f32x4*)tp, c1 = *(const f32x4*)(tp + 4);
                        f32x4 w0, w1;
                        w0[0] = v0[0] * c0[0] - v0[1] * c0[1]; w0[1] = v0[1] * c0[0] + v0[0] * c0[1];
                        w0[2] = v0[2] * c0[2] - v0[3] * c0[3]; w0[3] = v0[3] * c0[2] + v0[2] * c0[3];
                        w1[0] = v1[0] * c1[0] - v1[1] * c1[1]; w1[1] = v1[1] * c1[0] + v1[0] * c1[1];
                        w1[2] = v1[2] * c1[2] - v1[3] * c1[3]; w1[3] = v1[3] * c1[2] + v1[2] * c1[3];
                        v0 = w0; v1 = w1;
                    }
                    u32x4 w; w.x = cvt_pk_bf16(v0[0], v0[1]); w.y = cvt_pk_bf16(v0[2], v0[3]); w.z = cvt_pk_bf16(v1[0], v1[1]); w.w = cvt_pk_bf16(v1[2], v1[3]);
                    *(u32x4*)(O + (size_t)row * QMP + col0) = w;
                }
            }
    }
};
struct EpiUKV {
    static constexpr bool PERM = true, AFTER_DRAIN = false, KHOOK = false, PREF = false;
    bf16_t* O; const ssq_t* ssq;
    __device__ __forceinline__ void operator()(const f32x4 (&acc)[2][2][4][2], const Unit& u, int wr, int wc, int fr, int fq) const {
        const int row0 = u.pm * BM + wr * 64 + fr;
        ssq_t sv[8]; float rsv[8];
#pragma unroll
        for (int i = 0; i < 8; ++i) sv[i] = ssq[row0 + (i >> 2) * HALF + (i & 3) * 16];
#pragma unroll
        for (int i = 0; i < 8; ++i) rsv[i] = 1.0f / sqrtf(ssq_val(sv[i]) * (1.0f / 256.0f) + EPS);
#pragma unroll
        for (int ai = 0; ai < 2; ++ai)
#pragma unroll
            for (int m = 0; m < 4; ++m) {
                const int row = row0 + ai * HALF + m * 16;
                const float rs = rsv[ai * 4 + m];
#pragma unroll
                for (int bj = 0; bj < 2; ++bj) {
                    const int col0 = u.pn * BM + bj * HALF + wc * 32 + 8 * fq;
                    const f32x4 v0 = acc[ai][bj][m][0] * rs, v1 = acc[ai][bj][m][1] * rs;
                    u32x4 w; w.x = cvt_pk_bf16(v0[0], v0[1]); w.y = cvt_pk_bf16(v0[2], v0[3]); w.z = cvt_pk_bf16(v1[0], v1[1]); w.w = cvt_pk_bf16(v1[2], v1[3]);
                    *(u32x4*)(O + (size_t)row * KVP + col0) = w;
                }
            }
    }
};
template <bool GN> struct EpiRes {
    static constexpr bool PERM = true, AFTER_DRAIN = false, KHOOK = GN, PREF = false;
    const bf16_t* base; bf16_t* out; const float* gate; bf16_t* xg; const float* nw; const float* sc; ssq_t* ssq; const ssq_t* gsa; const ssq_t* gsb; const ssq_t* gsc;
    __device__ __forceinline__ void prefetch(const Unit& u, int par, PG8_LAS unsigned char* lds, int tid) const {
        if (tid < BM) {
            const int row = u.pm * BM + tid;
            const float sa = ssq_val(gsa[row]) * (1.0f / 384.0f) + EPS, sb = ssq_val(gsb[row]) * (1.0f / 384.0f) + EPS, sc_ = ssq_val(gsc[row]) * (1.0f / 256.0f) + EPS;
            PG8_LAS float* rp = (PG8_LAS float*)(lds + STAGE_BYTES + 1024) + par * 512;
            rp[tid] = sqrtf(sb / sa); rp[256 + tid] = sqrtf(sc_ / sb);
        }
    }
    __device__ __forceinline__ void khook(f32x4 (&acc)[2][2][4][2], int t, int wr, int fr, int par, PG8_LAS unsigned char* lds) const {
        const PG8_LAS float* rp = (const PG8_LAS float*)(lds + STAGE_BYTES + 1024) + par * 512 + (t == 6 ? 0 : 256) + wr * 64 + fr;
#pragma unroll
        for (int i = 0; i < 8; ++i) {
            const float r = rp[(i >> 2) * HALF + (i & 3) * 16];
#pragma unroll
            for (int bj = 0; bj < 2; ++bj)
#pragma unroll
                for (int n = 0; n < 2; ++n) acc[i >> 2][bj][i & 3][n] *= r;
        }
    }
    __device__ __forceinline__ void operator()(const f32x4 (&acc)[2][2][4][2], const Unit& u, int wr, int wc, int fr, int fq) const {
        float rc[8];
        if constexpr (GN) { ssq_t sc_[8];
#pragma unroll
            for (int i = 0; i < 8; ++i) sc_[i] = gsc[u.pm * BM + wr * 64 + fr + (i >> 2) * HALF + (i & 3) * 16];
#pragma unroll
            for (int i = 0; i < 8; ++i) rc[i] = 1.0f / sqrtf(ssq_val(sc_[i]) * (1.0f / 256.0f) + EPS); }
        const int col0 = u.pn * BM + wc * 32 + 8 * fq; const int b = (u.pm * BM) >> 12;
        const float* gp = gate + (size_t)b * NMOD + col0; const float* sp = sc + (size_t)b * NMOD + col0;
        f32x4 g[2][2], cf[2][2];
#pragma unroll
        for (int bj = 0; bj < 2; ++bj) {
            g[bj][0] = *(const f32x4*)(gp + bj * HALF); g[bj][1] = *(const f32x4*)(gp + bj * HALF + 4);
            const f32x4 n0 = *(const f32x4*)(nw + col0 + bj * HALF), n1 = *(const f32x4*)(nw + col0 + bj * HALF + 4);
            const f32x4 c0 = *(const f32x4*)(sp + bj * HALF), c1 = *(const f32x4*)(sp + bj * HALF + 4);
            cf[bj][0] = n0 * (c0 + 1.0f); cf[bj][1] = n1 * (c1 + 1.0f);
        }
#pragma unroll
        for (int ai = 0; ai < 2; ++ai)
#pragma unroll
        for (int mp = 0; mp < 4; mp += 2) {
            u32x4 bv[2][2];
#pragma unroll
            for (int mm = 0; mm < 2; ++mm)
#pragma unroll
                for (int bj = 0; bj < 2; ++bj)
                    bv[mm][bj] = *(gl_u32x4*)(PG8_GCPTR(base) + (unsigned)((u.pm * BM + ai * HALF + wr * 64 + (mp + mm) * 16 + fr) * DM + col0 + bj * HALF) * 2u);
#pragma unroll
            for (int mm = 0; mm < 2; ++mm) {
                const int m = mp + mm;
                const int row = u.pm * BM + ai * HALF + wr * 64 + m * 16 + fr; float q = 0.f;
#pragma unroll
                for (int bj = 0; bj < 2; ++bj) {
                    const unsigned offb = (unsigned)(row * DM + col0 + bj * HALF) * 2u;
                    const u32x4 bw = bv[mm][bj];
                    const f32x4 b0 = (f32x4){__uint_as_float(bw.x << 16), __uint_as_float(bw.x & 0xffff0000u), __uint_as_float(bw.y << 16), __uint_as_float(bw.y & 0xffff0000u)};
                    const f32x4 b1 = (f32x4){__uint_as_float(bw.z << 16), __uint_as_float(bw.z & 0xffff0000u), __uint_as_float(bw.w << 16), __uint_as_float(bw.w & 0xffff0000u)};
                    f32x4 a0 = acc[ai][bj][m][0], a1 = acc[ai][bj][m][1]; if constexpr (GN) { a0 *= rc[ai * 4 + m]; a1 *= rc[ai * 4 + m]; }
                    const f32x4 o0 = b0 + g[bj][0] * a0, o1 = b1 + g[bj][1] * a1;
                    u32x4 wo; wo.x = cvt_pk_bf16(o0[0], o0[1]); wo.y = cvt_pk_bf16(o0[2], o0[3]); wo.z = cvt_pk_bf16(o1[0], o1[1]); wo.w = cvt_pk_bf16(o1[2], o1[3]);
                    *(gs_u32x4*)(PG8_GPTR(out) + offb) = wo;
                    if (xg) {
                        const f32x4 h0 = o0 * cf[bj][0], h1 = o1 * cf[bj][1];
                        u32x4 w; w.x = cvt_pk_bf16(h0[0], h0[1]); w.y = cvt_pk_bf16(h0[2], h0[3]); w.z = cvt_pk_bf16(h1[0], h1[1]); w.w = cvt_pk_bf16(h1[2], h1[3]);
                        *(gs_u32x4*)(PG8_GPTR(xg) + offb) = w;
                        q += (o0[0] * o0[0] + o0[1] * o0[1]) + (o0[2] * o0[2] + o0[3] * o0[3]) + (o1[0] * o1[0] + o1[1] * o1[1]) + (o1[2] * o1[2] + o1[3] * o1[3]);
                    }
                }
                if (xg) ssq_put(ssq, row, q, fr, fq);
            }
        }
    }
};
struct EpiGU {
    static constexpr bool PERM = true, AFTER_DRAIN = false, KHOOK = false, PREF = true;
    bf16_t* O; const ssq_t* ssqx; const float* shw;
    __device__ __forceinline__ void prefetch(const Unit& u, int par, PG8_LAS unsigned char* lds, int tid) const {
        PG8_LAS float* rp = (PG8_LAS float*)(lds + STAGE_BYTES + 5120) + par * 512;
        if (tid < BM) rp[tid] = 1.0f / sqrtf(ssq_val(ssqx[u.pm * BM + tid]) * (1.0f / DM) + EPS);
        else rp[tid] = shw[(size_t)((u.pm * BM) >> 12) * 7680 + u.pn * BM + (tid - BM)];
    }
    __device__ __forceinline__ void operator()(const f32x4 (&acc)[2][2][4][2], const Unit& u, int wr, int wc, int fr, int fq, int par, PG8_LAS unsigned char* lds) const {
        const int row0 = u.pm * BM + wr * 64 + fr, col0 = u.pn * HALF + wc * 32 + 8 * fq;
        const PG8_LAS float* rp = (const PG8_LAS float*)(lds + STAGE_BYTES + 5120) + par * 512;
        const PG8_LAS float* sp = rp + 256 + wc * 32 + 8 * fq;
        const f32x4 sg0 = *(const PG8_LAS f32x4*)sp, sg1 = *(const PG8_LAS f32x4*)(sp + 4), su0 = *(const PG8_LAS f32x4*)(sp + HALF), su1 = *(const PG8_LAS f32x4*)(sp + HALF + 4);
        float rsv[8];
#pragma unroll
        for (int i = 0; i < 8; ++i) rsv[i] = rp[(i >> 2) * HALF + wr * 64 + (i & 3) * 16 + fr];
#pragma unroll
        for (int ai = 0; ai < 2; ++ai)
#pragma unroll
            for (int m = 0; m < 4; ++m) {
                const int row = row0 + ai * HALF + m * 16;
                const float rs = rsv[ai * 4 + m];
                const f32x4 g0 = acc[ai][0][m][0] * rs + sg0, g1 = acc[ai][0][m][1] * rs + sg1, u0 = acc[ai][1][m][0] * rs + su0, u1 = acc[ai][1][m][1] * rs + su1;
                f32x4 h0, h1;
                { const f32x2 a = swiglu_pk((f32x2){g0[0], g0[1]}, (f32x2){u0[0], u0[1]}), b2 = swiglu_pk((f32x2){g0[2], g0[3]}, (f32x2){u0[2], u0[3]});
                  const f32x2 c = swiglu_pk((f32x2){g1[0], g1[1]}, (f32x2){u1[0], u1[1]}), d = swiglu_pk((f32x2){g1[2], g1[3]}, (f32x2){u1[2], u1[3]});
                  h0 = (f32x4){a.x, a.y, b2.x, b2.y}; h1 = (f32x4){c.x, c.y, d.x, d.y}; }
                u32x4 w; w.x = cvt_pk_bf16(h0[0], h0[1]); w.y = cvt_pk_bf16(h0[2], h0[3]); w.z = cvt_pk_bf16(h1[0], h1[1]); w.w = cvt_pk_bf16(h1[2], h1[3]);
                *(gs_u32x4*)(PG8_GPTR(O) + (unsigned)(row * FFN + col0) * 2u) = w;
            }
    }
};
}

constexpr int KSTR = 104, VSTR = 72, ABUF = 64 * KSTR * 2 + 64 * VSTR * 2;
__device__ __forceinline__ int crow(int r, int hi) { return (r & 3) + 8 * (r >> 2) + 4 * hi; }
typedef __attribute__((address_space(1))) const u32x4 g_u32x4;
typedef __attribute__((address_space(1))) const bf16x8 g_bf16x8;
typedef float f32x2_cv __attribute__((ext_vector_type(2))); typedef __bf16 bf16x2_cv __attribute__((ext_vector_type(2)));
__device__ __forceinline__ unsigned cvtpk_s(float lo, float hi) { f32x2_cv v = {lo, hi}; bf16x2_cv b = __builtin_convertvector(v, bf16x2_cv); return __builtin_bit_cast(unsigned, b); }
__device__ __forceinline__ float max3f(float a, float b, float c) { float r; asm("v_max3_f32 %0, %1, %2, %3" : "=v"(r) : "v"(a), "v"(b), "v"(c)); return r; }
constexpr float RESC_THR = 8.0f;
constexpr int ABUF2 = 2 * ABUF;
template <int NDS, int MODE>
__device__ __forceinline__ void attn_unit(LAS unsigned char* lds, const bf16_t* Q, int qp, const bf16_t* K, int kp, const bf16_t* KR, int krp, const bf16_t* V, int vp,
                                          bf16_t* O, int op, int q0, float m_init, float l_init, unsigned long long* gss  , const int wave_s) {
    const int tid = opaque_tid(wave_s), lane = tid & 63, wid = __builtin_amdgcn_readfirstlane(tid >> 6), r32 = lane & 31, hi = lane >> 5;
    const int qw0 = q0 + 32 * wid;
    if (wid < 4) __builtin_amdgcn_s_setprio(1); else __builtin_amdgcn_s_setprio(0);
    bf16x8 qr[NDS];
    { const bf16_t* qrow = Q + (size_t)(qw0 + r32) * qp + 8 * hi;
#pragma unroll
      for (int d0 = 0; d0 < NDS; ++d0) qr[d0] = *(g_bf16x8*)(qrow + 16 * d0); }
    const int tp0 = (MODE == 1) ? ((q0 >= 128 ? q0 - 128 : 0) >> 7) : 0, tp1 = (q0 + 256) >> 7;
    const int srow = tid >> 3, sch = tid & 7;
    const int vrow = lane, vch = wid;
    const int vpos = (vrow & ~12) | ((vrow & 4) << 1) | ((vrow & 8) >> 1);
    const unsigned koff = (unsigned)(srow * kp + 8 * sch) * 2u, voff = (unsigned)(vrow * vp + 8 * vch) * 2u, kroff = (unsigned)((tid >> 2) * krp + 8 * (tid & 3)) * 2u;
    const bool do_kr = (NDS == 6) && tid < 256;
    u32x4 kreg0, vreg0, krreg0 = (u32x4){0u, 0u, 0u, 0u}, kreg1, vreg1, krreg1 = (u32x4){0u, 0u, 0u, 0u};
#define AT_GLOAD(tp) do { const size_t ro_ = (size_t)(tp) * 128; \
        const char* kt_ = (const char*)(K + ro_ * kp); const char* vt2_ = (const char*)(V + ro_ * vp); \
        kreg0 = *(g_u32x4*)(kt_ + koff); kreg1 = *(g_u32x4*)(kt_ + (size_t)64 * kp * 2 + koff); vreg0 = *(g_u32x4*)(vt2_ + voff); vreg1 = *(g_u32x4*)(vt2_ + (size_t)64 * vp * 2 + voff); \
        if (do_kr) { const char* rt_ = (const char*)(KR + ro_ * krp); krreg0 = *(g_u32x4*)(rt_ + kroff); krreg1 = *(g_u32x4*)(rt_ + (size_t)64 * krp * 2 + kroff); } } while (0)
#define AT_LW1(boff, kreg, vreg, krreg) do { LAS unsigned char* kb_ = lds + (boff); LAS unsigned short* vt_ = (LAS unsigned short*)(kb_ + 64 * KSTR * 2); \
        *(LAS u32x4*)(kb_ + (srow * KSTR + 8 * sch) * 2) = kreg; \
        if (do_kr) *(LAS u32x4*)(kb_ + ((tid >> 2) * KSTR + 64 + 8 * (tid & 3)) * 2) = krreg; \
        vt_[(8 * vch + 0) * VSTR + vpos] = (unsigned short)(vreg.x & 0xffffu); vt_[(8 * vch + 1) * VSTR + vpos] = (unsigned short)(vreg.x >> 16); \
        vt_[(8 * vch + 2) * VSTR + vpos] = (unsigned short)(vreg.y & 0xffffu); vt_[(8 * vch + 3) * VSTR + vpos] = (unsigned short)(vreg.y >> 16); \
        vt_[(8 * vch + 4) * VSTR + vpos] = (unsigned short)(vreg.z & 0xffffu); vt_[(8 * vch + 5) * VSTR + vpos] = (unsigned short)(vreg.z >> 16); \
        vt_[(8 * vch + 6) * VSTR + vpos] = (unsigned short)(vreg.w & 0xffffu); vt_[(8 * vch + 7) * VSTR + vpos] = (unsigned short)(vreg.w >> 16); } while (0)
#define AT_LWRITE(buf) do { AT_LW1((buf) * ABUF2, kreg0, vreg0, krreg0); AT_LW1((buf) * ABUF2 + ABUF, kreg1, vreg1, krreg1); } while (0)
    f32x16 o0, o1;
#pragma unroll
    for (int r = 0; r < 16; ++r) { o0[r] = 0.f; o1[r] = 0.f; }
    float m_run = (MODE == 1) ? m_init : 0.f, l_run = l_init;
    bool first = (MODE == 0);
    f32x16 negm;
#pragma unroll
    for (int r = 0; r < 16; ++r) negm[r] = -m_run;
    AT_GLOAD(tp0); AT_LWRITE(0);
    __syncthreads();
    int buf = 0;
    for (int tp = tp0; tp < tp1; ++tp) {
        if (tp + 1 < tp1) AT_GLOAD(tp + 1);
#pragma unroll
        for (int h = 0; h < 2; ++h) {
        const int kv0 = (2 * tp + h) * 64;
        bool active, needmask;
        if (MODE == 0) { active = kv0 <= qw0 + 31; needmask = kv0 + 63 > qw0; }
        else { active = (kv0 <= qw0 + 31) && (kv0 + 63 >= qw0 - 127); needmask = !((kv0 + 63 <= qw0) && (kv0 >= qw0 + 31 - 127)); }
        if (active) {
            const LAS unsigned char* kb = lds + buf * ABUF2 + h * ABUF + (r32 * KSTR + 8 * hi) * 2;
            const LAS unsigned char* vb = lds + buf * ABUF2 + h * ABUF + 64 * KSTR * 2 + (r32 * VSTR + 8 * hi) * 2;
            f32x16 p0, p1;
            { bf16x8 ka_[NDS], kc_[NDS];
#pragma unroll
              for (int d0 = 0; d0 < NDS; ++d0) { ka_[d0] = *(const LAS bf16x8*)(kb + d0 * 32); kc_[d0] = *(const LAS bf16x8*)(kb + 32 * KSTR * 2 + d0 * 32); }
              __builtin_amdgcn_sched_barrier(0);
#pragma unroll
              for (int d0 = 0; d0 < NDS; ++d0) {
                if (d0 == 0) { p0 = __builtin_amdgcn_mfma_f32_32x32x16_bf16(ka_[0], qr[0], negm, 0, 0, 0); p1 = __builtin_amdgcn_mfma_f32_32x32x16_bf16(kc_[0], qr[0], negm, 0, 0, 0); }
                else { p0 = __builtin_amdgcn_mfma_f32_32x32x16_bf16(ka_[d0], qr[d0], p0, 0, 0, 0); p1 = __builtin_amdgcn_mfma_f32_32x32x16_bf16(kc_[d0], qr[d0], p1, 0, 0, 0); }
              } }
            bf16x8 vf_[8];
#pragma unroll
            for (int c = 0; c < 4; ++c) { vf_[2 * c] = *(const LAS bf16x8*)(vb + c * 32); vf_[2 * c + 1] = *(const LAS bf16x8*)(vb + 32 * VSTR * 2 + c * 32); }
            __builtin_amdgcn_sched_barrier(0);
            asm volatile("s_nop 15\n\ts_nop 7" : "+v"(p0), "+v"(p1));
            if (needmask) {
                const int qa = qw0 + r32;
#pragma unroll
                for (int r = 0; r < 16; ++r) {
                    const int kv = kv0 + crow(r, hi);
                    bool k0 = kv > qa, k1 = kv + 32 > qa;
                    if (MODE == 1) { k0 = k0 || (kv + 128 <= qa); k1 = k1 || (kv + 32 + 128 <= qa); }
                    if (k0) p0[r] = -1e30f;
                    if (k1) p1[r] = -1e30f;
                }
            }
            float mxa = max3f(p0[0], p0[1], p1[0]), mxb = max3f(p0[2], p0[3], p1[1]); mxa = max3f(mxa, p1[2], p1[3]);
#pragma unroll
            for (int r = 4; r < 16; r += 4) { mxa = max3f(mxa, p0[r], p0[r + 1]); mxb = max3f(mxb, p0[r + 2], p0[r + 3]); mxa = max3f(mxa, p1[r], p1[r + 1]); mxb = max3f(mxb, p1[r + 2], p1[r + 3]); }
            float mx = max3f(mxa, mxb, mxb);
            mx = max3f(mx, shfl_x(mx, 32, lane), mx);
            if (first || __builtin_amdgcn_ballot_w64(mx > RESC_THR) != 0ull) {
                const float dl = first ? mx : fmaxf(mx, 0.f);
                const float f = first ? 1.0f : __builtin_amdgcn_exp2f(-dl);
                m_run += dl; l_run *= f;
#pragma unroll
                for (int r = 0; r < 16; ++r) { p0[r] -= dl; p1[r] -= dl; o0[r] *= f; o1[r] *= f; negm[r] = -m_run; }
                first = false;
            }
            float ls0 = 0.f, ls1 = 0.f;
#define AT_Q(P, B, c) do { \
            _Pragma("unroll") for (int r = 0; r < 8; ++r) P[(B) + r] = __builtin_amdgcn_exp2f(P[(B) + r]); \
            ls0 += (P[(B)] + P[(B) + 1]) + (P[(B) + 2] + P[(B) + 3]); ls1 += (P[(B) + 4] + P[(B) + 5]) + (P[(B) + 6] + P[(B) + 7]); \
            u32x4 w_; w_.x = cvtpk_s(P[(B)], P[(B) + 1]); w_.y = cvtpk_s(P[(B) + 2], P[(B) + 3]); w_.z = cvtpk_s(P[(B) + 4], P[(B) + 5]); w_.w = cvtpk_s(P[(B) + 6], P[(B) + 7]); \
            const bf16x8 pf_ = __builtin_bit_cast(bf16x8, w_); \
            o0 = __builtin_amdgcn_mfma_f32_32x32x16_bf16(vf_[2 * (c)], pf_, o0, 0, 0, 0); o1 = __builtin_amdgcn_mfma_f32_32x32x16_bf16(vf_[2 * (c) + 1], pf_, o1, 0, 0, 0); } while (0)
            AT_Q(p0, 0, 0); AT_Q(p0, 8, 1); AT_Q(p1, 0, 2); AT_Q(p1, 8, 3);
#undef AT_Q
            l_run += ls0 + ls1;
#pragma unroll
            for (int i_ = 0; i_ < 4; ++i_) { __builtin_amdgcn_sched_group_barrier(0x002, 20, 0); __builtin_amdgcn_sched_group_barrier(0x008, 2, 0); }
        }
        }
        if (tp + 1 < tp1) AT_LWRITE(buf ^ 1);
        __syncthreads();
        buf ^= 1;
    }
#undef AT_GLOAD
#undef AT_LW1
#undef AT_LWRITE
    const float lt = l_run + shfl_x(l_run, 32, lane);
    const float inv = 1.0f / lt;
    bf16_t* orow = O + (size_t)(qw0 + r32) * op + 4 * hi;
#pragma unroll
    for (int rg = 0; rg < 4; ++rg) {
        u32x2 a, b;
        a.x = cvtpk(o0[4 * rg] * inv, o0[4 * rg + 1] * inv); a.y = cvtpk(o0[4 * rg + 2] * inv, o0[4 * rg + 3] * inv);
        b.x = cvtpk(o1[4 * rg] * inv, o1[4 * rg + 1] * inv); b.y = cvtpk(o1[4 * rg + 2] * inv, o1[4 * rg + 3] * inv);
        *(u32x2*)(orow + 8 * rg) = a; *(u32x2*)(orow + 32 + 8 * rg) = b;
    }
    { float q = 0.f;
#pragma unroll
      for (int r = 0; r < 16; ++r) { const float a = o0[r] * inv, b = o1[r] * inv; q += a * a + b * b; }
      q += shfl_x(q, 32, lane);
      if (hi == 0) __hip_atomic_fetch_add(gss + qw0 + r32, (unsigned long long)(q * 16777216.0f), __ATOMIC_RELAXED, __HIP_MEMORY_SCOPE_AGENT); }
    __builtin_amdgcn_s_setprio(0);
}

constexpr int SWK = 72, SWT = 2 * 64 * SWK * 2;
__device__ __forceinline__ void swa_unit3(LAS unsigned char* lds, const bf16_t* pb  , bf16_t* Yb  , int q0, int kvh,
                                          const float* sinks  , unsigned long long* gss, const int wave_s) {
    const int tid = opaque_tid(wave_s), lane = tid & 63, wid = __builtin_amdgcn_readfirstlane(tid >> 6), r32 = lane & 31, hi = lane >> 5;
    const int qw0 = q0 + 32 * wid;
    const int kstart = q0 >= 128 ? q0 - 128 : 0, ntile = (q0 + 256 - kstart) >> 6;
    bf16x8 qr[3][4];
#pragma unroll
    for (int g = 0; g < 3; ++g) { const bf16_t* qrow = pb + (size_t)(qw0 + r32) * PJP + PC_AQ + 64 * (3 * kvh + g) + 8 * hi;
#pragma unroll
        for (int d0 = 0; d0 < 4; ++d0) qr[g][d0] = *(g_bf16x8*)(qrow + 16 * d0); }
    {
        const int srow = tid >> 3, sch = tid & 7, vrow = lane, vch = wid;
        const int vpos = (vrow & ~12) | ((vrow & 4) << 1) | ((vrow & 8) >> 1);
        const bf16_t* kg = pb + (size_t)(kstart + srow) * PJP + PC_AK + 64 * kvh + 8 * sch;
        const bf16_t* vg = pb + (size_t)(kstart + vrow) * PJP + PC_AV + 64 * kvh + 8 * vch;
        u32x4 kreg[6], vreg[6];
#pragma unroll
        for (int t = 0; t < 6; ++t) if (t < ntile) { kreg[t] = *(g_u32x4*)(kg + (size_t)t * 64 * PJP); vreg[t] = *(g_u32x4*)(vg + (size_t)t * 64 * PJP); }
#pragma unroll
        for (int t = 0; t < 6; ++t) if (t < ntile) {
            LAS unsigned char* kb_ = lds + t * SWT; LAS unsigned short* vt_ = (LAS unsigned short*)(kb_ + 64 * SWK * 2);
            *(LAS u32x4*)(kb_ + (srow * SWK + 8 * sch) * 2) = kreg[t];
            const u32x4 vr = vreg[t];
            vt_[(8 * vch + 0) * SWK + vpos] = (unsigned short)(vr.x & 0xffffu); vt_[(8 * vch + 1) * SWK + vpos] = (unsigned short)(vr.x >> 16);
            vt_[(8 * vch + 2) * SWK + vpos] = (unsigned short)(vr.y & 0xffffu); vt_[(8 * vch + 3) * SWK + vpos] = (unsigned short)(vr.y >> 16);
            vt_[(8 * vch + 4) * SWK + vpos] = (unsigned short)(vr.z & 0xffffu); vt_[(8 * vch + 5) * SWK + vpos] = (unsigned short)(vr.z >> 16);
            vt_[(8 * vch + 6) * SWK + vpos] = (unsigned short)(vr.w & 0xffffu); vt_[(8 * vch + 7) * SWK + vpos] = (unsigned short)(vr.w >> 16);
        }
    }
    __syncthreads();
#pragma unroll
    for (int g = 0; g < 3; ++g) {
        const int hq = 3 * kvh + g;
        float m_run = sinks[hq] * LOG2E, l_run = 0.5f;
        f32x16 o0, o1, negm;
#pragma unroll
        for (int r = 0; r < 16; ++r) { o0[r] = 0.f; o1[r] = 0.f; negm[r] = -m_run; }
#pragma unroll 1
        for (int t = 0; t < ntile; ++t) {
            const int kv0 = kstart + 64 * t;
            const bool active = (kv0 <= qw0 + 31) && (kv0 + 63 >= qw0 - 127);
            if (!active) continue;
            const bool needmask = !((kv0 + 63 <= qw0) && (kv0 >= qw0 + 31 - 127));
            const LAS unsigned char* kb = lds + t * SWT + (r32 * SWK + 8 * hi) * 2;
            const LAS unsigned char* vb = lds + t * SWT + 64 * SWK * 2 + (r32 * SWK + 8 * hi) * 2;
            f32x16 p0, p1;
            { bf16x8 ka_[4], kc_[4];
#pragma unroll
              for (int d0 = 0; d0 < 4; ++d0) { ka_[d0] = *(const LAS bf16x8*)(kb + d0 * 32); kc_[d0] = *(const LAS bf16x8*)(kb + 32 * SWK * 2 + d0 * 32); }
              __builtin_amdgcn_sched_barrier(0);
#pragma unroll
              for (int d0 = 0; d0 < 4; ++d0) {
                if (d0 == 0) { p0 = __builtin_amdgcn_mfma_f32_32x32x16_bf16(ka_[0], qr[g][0], negm, 0, 0, 0); p1 = __builtin_amdgcn_mfma_f32_32x32x16_bf16(kc_[0], qr[g][0], negm, 0, 0, 0); }
                else { p0 = __builtin_amdgcn_mfma_f32_32x32x16_bf16(ka_[d0], qr[g][d0], p0, 0, 0, 0); p1 = __builtin_amdgcn_mfma_f32_32x32x16_bf16(kc_[d0], qr[g][d0], p1, 0, 0, 0); }
              } }
            bf16x8 vf_[8];
#pragma unroll
            for (int c = 0; c < 4; ++c) { vf_[2 * c] = *(const LAS bf16x8*)(vb + c * 32); vf_[2 * c + 1] = *(const LAS bf16x8*)(vb + 32 * SWK * 2 + c * 32); }
            __builtin_amdgcn_sched_barrier(0);
            asm volatile("s_nop 15\n\ts_nop 7" : "+v"(p0), "+v"(p1));
            if (needmask) {
                const int qa = qw0 + r32;
#pragma unroll
                for (int r = 0; r < 16; ++r) {
                    const int kv = kv0 + crow(r, hi);
                    const bool k0 = (kv > qa) || (kv + 128 <= qa), k1 = (kv + 32 > qa) || (kv + 32 + 128 <= qa);
                    if (k0) p0[r] = -1e30f;
                    if (k1) p1[r] = -1e30f;
                }
            }
            float mxa = max3f(p0[0], p0[1], p1[0]), mxb = max3f(p0[2], p0[3], p1[1]); mxa = max3f(mxa, p1[2], p1[3]);
#pragma unroll
            for (int r = 4; r < 16; r += 4) { mxa = max3f(mxa, p0[r], p0[r + 1]); mxb = max3f(mxb, p0[r + 2], p0[r + 3]); mxa = max3f(mxa, p1[r], p1[r + 1]); mxb = max3f(mxb, p1[r + 2], p1[r + 3]); }
            float mx = max3f(mxa, mxb, mxb);
            mx = max3f(mx, shfl_x(mx, 32, lane), mx);
            if (__builtin_amdgcn_ballot_w64(mx > RESC_THR) != 0ull) {
                const float dl = fmaxf(mx, 0.f), f = __builtin_amdgcn_exp2f(-dl);
                m_run += dl; l_run *= f;
#pragma unroll
                for (int r = 0; r < 16; ++r) { p0[r] -= dl; p1[r] -= dl; o0[r] *= f; o1[r] *= f; negm[r] = -m_run; }
            }
            float ls0 = 0.f, ls1 = 0.f;
#define SW_Q(P, B, c) do { \
            _Pragma("unroll") for (int r = 0; r < 8; ++r) P[(B) + r] = __builtin_amdgcn_exp2f(P[(B) + r]); \
            ls0 += (P[(B)] + P[(B) + 1]) + (P[(B) + 2] + P[(B) + 3]); ls1 += (P[(B) + 4] + P[(B) + 5]) + (P[(B) + 6] + P[(B) + 7]); \
            u32x4 w_; w_.x = cvtpk_s(P[(B)], P[(B) + 1]); w_.y = cvtpk_s(P[(B) + 2], P[(B) + 3]); w_.z = cvtpk_s(P[(B) + 4], P[(B) + 5]); w_.w = cvtpk_s(P[(B) + 6], P[(B) + 7]); \
            const bf16x8 pf_ = __builtin_bit_cast(bf16x8, w_); \
            o0 = __builtin_amdgcn_mfma_f32_32x32x16_bf16(vf_[2 * (c)], pf_, o0, 0, 0, 0); o1 = __builtin_amdgcn_mfma_f32_32x32x16_bf16(vf_[2 * (c) + 1], pf_, o1, 0, 0, 0); } while (0)
            SW_Q(p0, 0, 0); SW_Q(p0, 8, 1); SW_Q(p1, 0, 2); SW_Q(p1, 8, 3);
#undef SW_Q
            l_run += ls0 + ls1;
        }
        const float lt = l_run + shfl_x(l_run, 32, lane);
        const float inv = 1.0f / lt;
        bf16_t* orow = Yb + (size_t)(qw0 + r32) * DM + 64 * hq + 4 * hi;
#pragma unroll
        for (int rg = 0; rg < 4; ++rg) {
            u32x2 a, b;
            a.x = cvtpk(o0[4 * rg] * inv, o0[4 * rg + 1] * inv); a.y = cvtpk(o0[4 * rg + 2] * inv, o0[4 * rg + 3] * inv);
            b.x = cvtpk(o1[4 * rg] * inv, o1[4 * rg + 1] * inv); b.y = cvtpk(o1[4 * rg + 2] * inv, o1[4 * rg + 3] * inv);
            *(u32x2*)(orow + 8 * rg) = a; *(u32x2*)(orow + 32 + 8 * rg) = b;
        }
        { float q = 0.f;
#pragma unroll
          for (int r = 0; r < 16; ++r) { const float a = o0[r] * inv, b = o1[r] * inv; q += a * a + b * b; }
          q += shfl_x(q, 32, lane);
          if (hi == 0) __hip_atomic_fetch_add(gss + qw0 + r32, (unsigned long long)(q * 16777216.0f), __ATOMIC_RELAXED, __HIP_MEMORY_SCOPE_AGENT); }
    }
    __syncthreads();
}

constexpr int SSTR = 136;
__device__ __forceinline__ void sgu_unit(LAS unsigned char* lds, const bf16_t* proj, bf16_t* Y, const bf16_t* wsb  , const float* lnw, const float* lnb, const float* bs  , int row0, unsigned long long* gss, const int wave_s) {
    const int tid = opaque_tid(wave_s), lane = tid & 63, wid = __builtin_amdgcn_readfirstlane(tid >> 6), r32 = lane & 31, hi = lane >> 5;
    LAS unsigned short* vt = (LAS unsigned short*)lds;
    {
        const int s = tid >> 2, q = tid & 3;
        const u32x4* src = (const u32x4*)(proj + (size_t)(row0 + s) * PJP + PC_CV + 64 * q);
        float v[64]; float sum = 0.f;
#pragma unroll
        for (int i = 0; i < 8; ++i) { const u32x4 w = src[i];
            v[8 * i + 0] = bflo(w.x); v[8 * i + 1] = bfhi(w.x); v[8 * i + 2] = bflo(w.y); v[8 * i + 3] = bfhi(w.y);
            v[8 * i + 4] = bflo(w.z); v[8 * i + 5] = bfhi(w.z); v[8 * i + 6] = bflo(w.w); v[8 * i + 7] = bfhi(w.w); }
#pragma unroll
        for (int i = 0; i < 64; ++i) sum += v[i];
        sum += shfl_x(sum, 1, lane); sum += shfl_x(sum, 2, lane);
        const float mu = sum * (1.0f / 256.0f); float sq = 0.f;
#pragma unroll
        for (int i = 0; i < 64; ++i) { v[i] -= mu; sq += v[i] * v[i]; }
        sq += shfl_x(sq, 1, lane); sq += shfl_x(sq, 2, lane);
        const float rstd = 1.0f / sqrtf(sq * (1.0f / 256.0f) + EPS);
#pragma unroll
        for (int i = 0; i < 64; i += 2) {
            const int c = 64 * q + i;
            const float a = v[i] * rstd * lnw[c] + lnb[c], b = v[i + 1] * rstd * lnw[c + 1] + lnb[c + 1];
            const unsigned w = cvtpk(a, b);
            vt[c * SSTR + s] = (unsigned short)(w & 0xffffu); vt[(c + 1) * SSTR + s] = (unsigned short)(w >> 16);
        }
    }
    __syncthreads();
    const int g = wid >> 1, dh = wid & 1;
    const LAS unsigned char* ab = lds + ((64 * g + 32 * dh + r32) * SSTR + 8 * hi) * 2;
    const bf16_t* wg = wsb + (size_t)g * 128 * 128;
#pragma unroll 1
    for (int tt = 0; tt < 4; ++tt) {
        f32x16 acc;
#pragma unroll
        for (int r = 0; r < 16; ++r) acc[r] = 0.f;
        const bf16_t* wrow = wg + (size_t)(32 * tt + r32) * 128 + 8 * hi;
        const int nk = 2 * (tt + 1);
        bf16x8 wf[8];
#pragma unroll
        for (int k = 0; k < 8; ++k) if (k < nk) wf[k] = *(g_bf16x8*)(wrow + 16 * k);
#pragma unroll
        for (int k = 0; k < 8; ++k) if (k < nk) {
            const bf16x8 a = *(const LAS bf16x8*)(ab + k * 32);
            acc = __builtin_amdgcn_mfma_f32_32x32x16_bf16(a, wf[k], acc, 0, 0, 0);
        }
        const int t = 32 * tt + r32; const size_t row = (size_t)row0 + t;
        const float bias = bs[g * 128 + t];
        const int cb = 64 * g + 32 * dh + 4 * hi; float qs = 0.f;
        u32x2 uwv[4];
#pragma unroll
        for (int rg = 0; rg < 4; ++rg) uwv[rg] = *(const u32x2*)(proj + row * PJP + PC_CU + cb + 8 * rg);
#pragma unroll
        for (int rg = 0; rg < 4; ++rg) {
            const u32x2 uw = uwv[rg];
            const float y0 = bflo(uw.x) * (acc[4 * rg] + bias), y1 = bfhi(uw.x) * (acc[4 * rg + 1] + bias), y2 = bflo(uw.y) * (acc[4 * rg + 2] + bias), y3 = bfhi(uw.y) * (acc[4 * rg + 3] + bias);
            u32x2 o; o.x = cvtpk(y0, y1); o.y = cvtpk(y2, y3);
            *(u32x2*)(Y + row * DM + 768 + cb + 8 * rg) = o;
            qs += (y0 * y0 + y1 * y1) + (y2 * y2 + y3 * y3);
        }
        qs += shfl_x(qs, 32, lane);
        if (hi == 0) __hip_atomic_fetch_add(gss + row, (unsigned long long)(qs * 16777216.0f), __ATOMIC_RELAXED, __HIP_MEMORY_SCOPE_AGENT);
    }
    __syncthreads();
}

__device__ __forceinline__ void norm_mod_pass(const float* x, const float* nw, const float* sh, const float* sc, bf16_t* H, int vcu, int ngw, const int wave_s) {
    const int tid_ = opaque_tid(wave_s), lane = tid_ & 63, gw = vcu * NWAVES + (tid_ >> 6);
    f32x4 wv[4];
#pragma unroll
    for (int j = 0; j < 4; ++j) wv[j] = *(const f32x4*)(nw + 4 * lane + 256 * j);
    for (int m_ = gw; m_ < REP_PASS * MTOK; m_ += ngw) {
        const int m = m_ % MTOK; const int b = m >> 12;
        const f32x4* xr = (const f32x4*)(x + (size_t)m * DM) + lane;
        f32x4 v[4]; float s = 0.f;
#pragma unroll
        for (int j = 0; j < 4; ++j) { v[j] = xr[64 * j]; s += (v[j].x * v[j].x + v[j].y * v[j].y) + (v[j].z * v[j].z + v[j].w * v[j].w); }
        const float rstd = 1.0f / sqrtf(wave_sum(s, lane) * (1.0f / DM) + EPS);
        unsigned long long* o8 = (unsigned long long*)(H + (size_t)m * DM) + lane;
#pragma unroll
        for (int j = 0; j < 4; ++j) {
            const f32x4 scv = *(const f32x4*)(sc + (size_t)b * NMOD + 4 * lane + 256 * j), shv = *(const f32x4*)(sh + (size_t)b * NMOD + 4 * lane + 256 * j);
            const f32x4 h = v[j] * rstd * wv[j] * (scv + 1.0f) + shv;
            o8[64 * j] = (unsigned long long)cvtpk(h.x, h.y) | ((unsigned long long)cvtpk(h.z, h.w) << 32);
        }
    }
}
__device__ __forceinline__ void group_norm_pass(const bf16_t* Y, const float* gwt, bf16_t* H, int vcu, int ngw, const int wave_s) {
    const int tid_ = opaque_tid(wave_s), lane = tid_ & 63, gw = vcu * NWAVES + (tid_ >> 6);
    const int seg = lane < 24 ? 0 : (lane < 48 ? 1 : 2);
    float g[16];
#pragma unroll
    for (int i = 0; i < 16; ++i) g[i] = gwt[16 * lane + i];
    for (int m_ = gw; m_ < REP_PASS * MTOK; m_ += ngw) {
        const int m = m_ % MTOK; const u32x4* yr = (const u32x4*)(Y + (size_t)m * DM + 16 * lane);
        const u32x4 a = yr[0], b = yr[1];
        float v[16];
        v[0] = bflo(a.x); v[1] = bfhi(a.x); v[2] = bflo(a.y); v[3] = bfhi(a.y); v[4] = bflo(a.z); v[5] = bfhi(a.z); v[6] = bflo(a.w); v[7] = bfhi(a.w);
        v[8] = bflo(b.x); v[9] = bfhi(b.x); v[10] = bflo(b.y); v[11] = bfhi(b.y); v[12] = bflo(b.z); v[13] = bfhi(b.z); v[14] = bflo(b.w); v[15] = bfhi(b.w);
        float s = 0.f;
#pragma unroll
        for (int i = 0; i < 16; ++i) s += v[i] * v[i];
        const float s0 = wave_sum(seg == 0 ? s : 0.f, lane), s1 = wave_sum(seg == 1 ? s : 0.f, lane), s2 = wave_sum(seg == 2 ? s : 0.f, lane);
        const float rstd = seg == 0 ? 1.0f / sqrtf(s0 * (1.0f / 384.0f) + EPS) : (seg == 1 ? 1.0f / sqrtf(s1 * (1.0f / 384.0f) + EPS) : 1.0f / sqrtf(s2 * (1.0f / 256.0f) + EPS));
        u32x4 oa, ob;
        oa.x = cvtpk(v[0] * rstd * g[0], v[1] * rstd * g[1]); oa.y = cvtpk(v[2] * rstd * g[2], v[3] * rstd * g[3]);
        oa.z = cvtpk(v[4] * rstd * g[4], v[5] * rstd * g[5]); oa.w = cvtpk(v[6] * rstd * g[6], v[7] * rstd * g[7]);
        ob.x = cvtpk(v[8] * rstd * g[8], v[9] * rstd * g[9]); ob.y = cvtpk(v[10] * rstd * g[10], v[11] * rstd * g[11]);
        ob.z = cvtpk(v[12] * rstd * g[12], v[13] * rstd * g[13]); ob.w = cvtpk(v[14] * rstd * g[14], v[15] * rstd * g[15]);
        u32x4* orow = (u32x4*)(H + (size_t)m * DM + 16 * lane);
        orow[0] = oa; orow[1] = ob;
    }
}
__device__ __forceinline__ void final_norm_pass(const bf16_t* x16, float* out, const float* nw, int vcu, int ngw, const int wave_s) {
    const int tid_ = opaque_tid(wave_s), lane = tid_ & 63, gw = vcu * NWAVES + (tid_ >> 6);
    f32x4 wv[4];
#pragma unroll
    for (int j = 0; j < 4; ++j) wv[j] = *(const f32x4*)(nw + 16 * lane + 4 * j);
    for (int m0 = 4 * gw; m0 < MTOK; m0 += 4 * ngw) {
        u32x4 a[4], b[4];
#pragma unroll
        for (int i = 0; i < 4; ++i) { const u32x4* xr = (const u32x4*)(x16 + (size_t)(m0 + i) * DM + 16 * lane); a[i] = xr[0]; b[i] = xr[1]; }
#pragma unroll
        for (int i = 0; i < 4; ++i) {
            f32x4 v[4];
            v[0] = (f32x4){bflo(a[i].x), bfhi(a[i].x), bflo(a[i].y), bfhi(a[i].y)}; v[1] = (f32x4){bflo(a[i].z), bfhi(a[i].z), bflo(a[i].w), bfhi(a[i].w)};
            v[2] = (f32x4){bflo(b[i].x), bfhi(b[i].x), bflo(b[i].y), bfhi(b[i].y)}; v[3] = (f32x4){bflo(b[i].z), bfhi(b[i].z), bflo(b[i].w), bfhi(b[i].w)};
            float s = 0.f;
#pragma unroll
            for (int j = 0; j < 4; ++j) s += (v[j].x * v[j].x + v[j].y * v[j].y) + (v[j].z * v[j].z + v[j].w * v[j].w);
            const float rstd = 1.0f / sqrtf(wave_sum(s, lane) * (1.0f / DM) + EPS);
            f32x4* orow = (f32x4*)(out + (size_t)(m0 + i) * DM + 16 * lane);
#pragma unroll
            for (int j = 0; j < 4; ++j) orow[j] = v[j] * rstd * wv[j];
        }
    }
}
__device__ __forceinline__ void xg_pass(const float* x, const float* nw, const float* sc, bf16_t* XGp, bf16_t* X16p, unsigned long long* ssq, int vcu, int ngw, const int wave_s) {
    const int tid_ = opaque_tid(wave_s), lane = tid_ & 63, gw = vcu * NWAVES + (tid_ >> 6);
    f32x4 wv[4];
#pragma unroll
    for (int j = 0; j < 4; ++j) wv[j] = *(const f32x4*)(nw + 4 * lane + 256 * j);
    for (int m0 = 2 * gw; m0 < MTOK; m0 += 2 * ngw) {
        const int b = m0 >> 12;
        f32x4 v[2][4], scv[4];
#pragma unroll
        for (int i = 0; i < 2; ++i)
#pragma unroll
            for (int j = 0; j < 4; ++j) v[i][j] = ((const f32x4*)(x + (size_t)(m0 + i) * DM) + lane)[64 * j];
#pragma unroll
        for (int j = 0; j < 4; ++j) scv[j] = *(const f32x4*)(sc + (size_t)b * NMOD + 4 * lane + 256 * j);
#pragma unroll
        for (int i = 0; i < 2; ++i) {
            const int m = m0 + i; float s = 0.f;
#pragma unroll
            for (int j = 0; j < 4; ++j) s += (v[i][j].x * v[i][j].x + v[i][j].y * v[i][j].y) + (v[i][j].z * v[i][j].z + v[i][j].w * v[i][j].w);
            s = wave_sum(s, lane);
            if (lane == 0) ssq[m] = (unsigned long long)(s * 16777216.0f);
            unsigned long long* o8 = (unsigned long long*)(XGp + (size_t)m * DM) + lane;
            unsigned long long* x8 = (unsigned long long*)(X16p + (size_t)m * DM) + lane;
#pragma unroll
            for (int j = 0; j < 4; ++j) {
                const f32x4 h = v[i][j] * wv[j] * (scv[j] + 1.0f);
                o8[64 * j] = (unsigned long long)cvtpk(h.x, h.y) | ((unsigned long long)cvtpk(h.z, h.w) << 32);
                x8[64 * j] = (unsigned long long)cvtpk(v[i][j].x, v[i][j].y) | ((unsigned long long)cvtpk(v[i][j].z, v[i][j].w) << 32);
            }
        }
    }
}
__device__ __forceinline__ void shw_tasks(const float* modp, const bf16_t* win, const bf16_t* wgu, float* shw, int vcu, int ngw, const int wave_s) {
    const int tid_ = opaque_tid(wave_s), lane = tid_ & 63, gw = vcu * NWAVES + (tid_ >> 6), r32 = lane & 31, hi = lane >> 5;
    for (int task = gw; task < DEPTH * 240; task += ngw) {
        const int l = task / 240, n0 = 32 * (task % 240);
        const bf16_t* wrow = (n0 < PJ) ? (win + l * WIN_L + (size_t)(n0 + r32) * DM) : (wgu + l * WGU_L + (size_t)(n0 - PJ + r32) * DM);
        const float* shp = modp + ((size_t)l * 16 + (r32 & 15)) * NMOD + (n0 < PJ ? 0 : 3 * DM) + 8 * hi;
        f32x16 acc;
#pragma unroll
        for (int r = 0; r < 16; ++r) acc[r] = 0.f;
#pragma unroll 16
        for (int k = 0; k < 64; ++k) {
            const f32x4 a0 = *(const f32x4*)(shp + 16 * k), a1 = *(const f32x4*)(shp + 16 * k + 4);
            u32x4 aw; aw.x = cvtpk(a0.x, a0.y); aw.y = cvtpk(a0.z, a0.w); aw.z = cvtpk(a1.x, a1.y); aw.w = cvtpk(a1.z, a1.w);
            const bf16x8 bfr = *(const bf16x8*)(wrow + 16 * k + 8 * hi);
            acc = __builtin_amdgcn_mfma_f32_32x32x16_bf16(__builtin_bit_cast(bf16x8, aw), bfr, acc, 0, 0, 0);
        }
#pragma unroll
        for (int r = 0; r < 8; ++r) shw[((size_t)l * 16 + crow(r, hi)) * 7680 + n0 + r32] = acc[r];
    }
}

__device__ __forceinline__ int map_col(int mat, int n) {
    if (mat == 0) {
        if (n < 512) { const int hh = n >> 6, i = n & 63; return hh * 64 + (i >> 1) + 32 * (i & 1); }
        if (n < 640) return n;
        if (n < 672) { const int i = n - 640; return 1280 + (i >> 1) + 16 * (i & 1); }
        if (n < 768) return -1;
        if (n < 1152) return 640 + (n - 768);
        if (n < 1408) return 1024 + (n - 1152);
        if (n < 1536) return -1;
        if (n < 1792) return 1312 + (n - 1536);
        return 1568 + (n - 1792);
    } else if (mat == 1) {
        if (n >= 576) return -1;
        const int h = n / 96, i = n - 96 * h;
        if (i < 64) return 96 * h + i;
        const int ii = i - 64; return 96 * h + 64 + (ii >> 1) + 16 * (ii & 1);
    } else if (mat == 4) {
        const int pn = n >> 8, bj = (n >> 7) & 1, i = n & 127; return (bj ? FFN : 0) + 128 * pn + i;
    }
    return n;
}
__device__ __forceinline__ void transpose_item(const float* W, int K, int Nsrc, bf16_t* WT, int kb, int nb, int mat, const float* kscale, LAS float* scr, int lane) {
    const int k0 = 64 * kb, n0 = 32 * nb;
    const int scol = map_col(mat, n0 + (lane & 31));
    float tv[32];
#pragma unroll
    for (int i = 0; i < 32; ++i) { const int kk = 2 * i + (lane >> 5); tv[i] = scol >= 0 ? W[(size_t)(k0 + kk) * Nsrc + scol] : 0.f; }
#pragma unroll
    for (int i = 0; i < 32; ++i) { const int kk = 2 * i + (lane >> 5); float v = tv[i]; if (kscale) v *= kscale[k0 + kk]; scr[kk * 33 + (lane & 31)] = v; }
    asm volatile("s_waitcnt lgkmcnt(0)" ::: "memory");
    const int c = lane & 7;
#pragma unroll
    for (int j = 0; j < 4; ++j) { const int n = (lane >> 3) + 8 * j; const LAS float* s = scr + (8 * c) * 33 + n;
        u32x4 o; o.x = cvtpk(s[0 * 33], s[1 * 33]); o.y = cvtpk(s[2 * 33], s[3 * 33]); o.z = cvtpk(s[4 * 33], s[5 * 33]); o.w = cvtpk(s[6 * 33], s[7 * 33]);
        *(u32x4*)(WT + (size_t)(n0 + n) * K + k0 + 8 * c) = o; }
    asm volatile("s_waitcnt lgkmcnt(0)" ::: "memory");
}
__device__ __forceinline__ void sincos_rev(float angf, float& c, float& s) {
    double rev = (double)angf * 0.15915494309189535; rev -= floor(rev);
    const double q4 = rev * 4.0; const double qn = rint(q4); const float r = (float)((q4 - qn) * 1.5707963267948966);
    const int q = ((int)qn) & 3; const float r2 = r * r;
    const float sn = r * (1.0f + r2 * (-1.0f / 6.0f + r2 * (1.0f / 120.0f + r2 * (-1.0f / 5040.0f + r2 * (1.0f / 362880.0f)))));
    const float cs = 1.0f + r2 * (-0.5f + r2 * (1.0f / 24.0f + r2 * (-1.0f / 720.0f + r2 * (1.0f / 40320.0f))));
    c = (q == 0) ? cs : (q == 1) ? -sn : (q == 2) ? -cs : sn;
    s = (q == 0) ? sn : (q == 1) ? cs : (q == 2) ? -sn : -cs;
}

__device__ __forceinline__ void prologue(const Args& A, LAS unsigned char* lds, int vcu, int G, const int wave_s) {
    const int tid = opaque_tid(wave_s), lane = tid & 63, wid = __builtin_amdgcn_readfirstlane(tid >> 6);
    unsigned char* ws = A.ws;
    {
        LAS float* cact = (LAS float*)lds;
        LAS float* red = (LAS float*)(lds + 65536);
        const float* c = A.in[1];
        for (int idx = tid; idx < NBATCH * DM; idx += NTHR) { const int b = idx >> 10, k = idx & 1023; cact[k * 16 + b] = silu_f(c[idx]); }
        __syncthreads();
        float* mod = (float*)(ws + WS_MOD);
        for (int tsk = vcu; tsk < DEPTH * 96; tsk += G) {
            const int l = tsk / 96, cgp = tsk % 96, n = 64 * cgp + lane;
            const float* wp = A.in[3] + ((size_t)l * DM + (size_t)wid * 128) * NMOD + n;
            float acc[16];
#pragma unroll
            for (int b = 0; b < 16; ++b) acc[b] = 0.f;
#pragma unroll 16
            for (int kk = 0; kk < 128; ++kk) {
                const float w = wp[(size_t)kk * NMOD];
                const LAS f32x4* cp = (const LAS f32x4*)(cact + (wid * 128 + kk) * 16);
                const f32x4 c0 = cp[0], c1 = cp[1], c2 = cp[2], c3 = cp[3];
                acc[0] += c0.x * w; acc[1] += c0.y * w; acc[2] += c0.z * w; acc[3] += c0.w * w;
                acc[4] += c1.x * w; acc[5] += c1.y * w; acc[6] += c1.z * w; acc[7] += c1.w * w;
                acc[8] += c2.x * w; acc[9] += c2.y * w; acc[10] += c2.z * w; acc[11] += c2.w * w;
                acc[12] += c3.x * w; acc[13] += c3.y * w; acc[14] += c3.z * w; acc[15] += c3.w * w;
            }
#pragma unroll
            for (int b = 0; b < 16; ++b) red[(wid * 16 + b) * 64 + lane] = acc[b];
            __syncthreads();
            for (int o = tid; o < 1024; o += NTHR) { const int b = o >> 6, nn = o & 63; float s = A.in[4][(size_t)l * NMOD + 64 * cgp + nn];
#pragma unroll
                for (int k8 = 0; k8 < 8; ++k8) s += red[(k8 * 16 + b) * 64 + nn];
                mod[((size_t)l * 16 + b) * NMOD + 64 * cgp + nn] = s; }
            __syncthreads();
        }
        __syncthreads();
    }
    {
        LAS float* scr = (LAS float*)(lds + wid * 16384);
        const int gw = vcu * NWAVES + wid, ngw = G * NWAVES;
        constexpr int I_IN = 16 * 64, I_UQ = 6 * 24, I_UKV = 4 * 24, I_OUT = 16 * 32, I_GU = 16 * 176, I_DN = 44 * 32, I_L = I_IN + I_UQ + I_UKV + I_OUT + I_GU + I_DN;
        for (int it = gw; it < DEPTH * I_L; it += ngw) {
            const int l = it / I_L; int r = it - l * I_L;
            if (r < I_IN) { transpose_item(A.in[6] + (size_t)l * DM * INC, DM, INC, (bf16_t*)(ws + WS_WIN) + l * WIN_L, r / 64, r % 64, 0, nullptr, scr, lane); continue; } r -= I_IN;
            if (r < I_UQ) { transpose_item(A.in[9] + (size_t)l * 384 * 576, 384, 576, (bf16_t*)(ws + WS_WUQ) + l * WUQ_L, r / 24, r % 24, 1, A.in[8] + l * 384, scr, lane); continue; } r -= I_UQ;
            if (r < I_UKV) { transpose_item(A.in[11] + (size_t)l * 256 * 768, 256, 768, (bf16_t*)(ws + WS_WUKV) + l * WUKV_L, r / 24, r % 24, 2, A.in[10] + l * 256, scr, lane); continue; } r -= I_UKV;
            if (r < I_OUT) { transpose_item(A.in[17] + (size_t)l * DM * DM, DM, DM, (bf16_t*)(ws + WS_WOUT) + l * WOUT_L, r / 32, r % 32, 3, A.in[16] + l * DM, scr, lane); continue; } r -= I_OUT;
            if (r < I_GU) { transpose_item(A.in[19] + (size_t)l * DM * 2 * FFN, DM, 2 * FFN, (bf16_t*)(ws + WS_WGU) + l * WGU_L, r / 176, r % 176, 4, nullptr, scr, lane); continue; } r -= I_GU;
            transpose_item(A.in[20] + (size_t)l * FFN * DM, FFN, DM, (bf16_t*)(ws + WS_WDN) + l * WDN_L, r / 32, r % 32, 5, nullptr, scr, lane);
        }
    }
    {
        const int gt = vcu * NTHR + tid, ngt = G * NTHR;
        bf16_t* wsb = (bf16_t*)(ws + WS_WS);
        for (int i = gt; i < DEPTH * 4 * 128 * 128 / 2; i += ngt) { const int e = 2 * i, s = e & 127, t = (e >> 7) & 127; const float a = s <= t ? A.in[14][e] : 0.f, b = (s + 1) <= t ? A.in[14][e + 1] : 0.f;
            ((unsigned*)wsb)[i] = cvtpk(a, b); }
        unsigned long long* ssqz = (unsigned long long*)(ws + WS_SSQ);
        for (int i = gt; i < DEPTH * 8 * MTOK; i += ngt) ssqz[i] = 0ull;
        f32x2* ra = (f32x2*)(ws + WS_ROPA); f32x2* rb = (f32x2*)(ws + WS_ROPB);
        const int* pos = (const int*)A.in[2];
        for (int i0 = gt; i0 < MTOK * 48; i0 += 4 * ngt) {
            int pv[4];
#pragma unroll
            for (int j = 0; j < 4; ++j) { const int i = i0 + j * ngt; pv[j] = (i < MTOK * 48) ? pos[i / 48] : 0; }
#pragma unroll
            for (int j = 0; j < 4; ++j) { const int i = i0 + j * ngt; if (i < MTOK * 48) { const int tok = i / 48, e = i - tok * 48; const float angf = (float)pv[j] * A.inv[e]; float c, s; sincos_rev(angf, c, s);
                if (e < 32) ra[(size_t)tok * 32 + e] = (f32x2){c, s}; else rb[(size_t)tok * 16 + (e - 32)] = (f32x2){c, s}; } }
        }
    }
}

#define RLX_AGENT __ATOMIC_RELAXED, __HIP_MEMORY_SCOPE_AGENT
#define XB_TMO      128
#define XB_XCNT(j)  (256  + 64 * (j))
#define XB_XSUB(j)  (1280 + 64 * (j))
#define XB_XGEN(j)  (2304 + 64 * (j))
#define XB_TOP      3328
#define XB_TOPGEN   3392
#define XCD_BAR_WORDS 3456
#define XB_SPIN_CAP (1u << 18)

__device__ __forceinline__ unsigned xb_ld(unsigned* p)              { return __hip_atomic_load(p, __ATOMIC_RELAXED, __HIP_MEMORY_SCOPE_AGENT); }
__device__ __forceinline__ unsigned xb_add(unsigned* p, unsigned v) { return __hip_atomic_fetch_add(p, v, __ATOMIC_RELAXED, __HIP_MEMORY_SCOPE_AGENT); }
__device__ __forceinline__ unsigned xb_xcc_id() { return (unsigned)__builtin_amdgcn_s_getreg((3 << 11) | 20) & 0xFu; }
#define XB_SPIN(cond, bar) do { unsigned _sp = 0; while (cond) { __builtin_amdgcn_s_sleep(1); \
    if ((++_sp & 255u) == 0u) { if (xb_ld(&(bar)[XB_TMO])) break; if (_sp > XB_SPIN_CAP) { atomicAdd(&(bar)[XB_TMO], 1u); break; } } } } while (0)

struct XcdBarrier {
    unsigned* bar; unsigned x;
    volatile LAS unsigned* st;
};

__device__ __forceinline__ XcdBarrier xcd_barrier_post(unsigned* bar, volatile LAS unsigned* st) {
    XcdBarrier b; b.bar = bar; b.x = xb_xcc_id(); b.st = st;
    if (threadIdx.x == 0) (void)xb_add(&bar[XB_XCNT(b.x)], 1u);
    return b;
}
__device__ __forceinline__ void xcd_barrier_complete(unsigned* bar, unsigned x, unsigned& nloc, unsigned& nx) {
    const unsigned G = gridDim.x * gridDim.y * gridDim.z;
    unsigned sum, cnt, mine, sp = 0u;
    for (;;) {
        sum = 0u; cnt = 0u; mine = 0u;
#pragma unroll
        for (unsigned j = 0; j < 16; ++j) { const unsigned c = xb_ld(&bar[XB_XCNT(j)]); sum += c; cnt += (c > 0u) ? 1u : 0u; mine = (j == x) ? c : mine; }
        if (sum == G) break;
        __builtin_amdgcn_s_sleep(1);
        if ((++sp & 255u) == 0u) { if (xb_ld(&bar[XB_TMO])) break; if (sp > XB_SPIN_CAP) { atomicAdd(&bar[XB_TMO], 1u); break; } }
    }
    nloc = mine > 0u ? mine : 1u; nx = cnt > 0u ? cnt : 1u;
}

__device__ __forceinline__ void xcd_barrier(const XcdBarrier& b) {
    asm volatile("s_waitcnt vmcnt(0)" ::: "memory");
    __syncthreads();
    if (threadIdx.x == 0) {
        unsigned* bar = b.bar;
        __builtin_amdgcn_s_waitcnt(0);
        unsigned nloc = b.st[0], nx = b.st[1];
        if (nloc == 0u) { xcd_barrier_complete(bar, b.x, nloc, nx); b.st[0] = nloc; b.st[1] = nx; }
        const unsigned old = xb_add(&bar[XB_XSUB(b.x)], 1u);
        const unsigned gen = old / nloc;
        if (old + 1u == (gen + 1u) * nloc) {
            __builtin_amdgcn_fence(__ATOMIC_RELEASE, "agent");
            asm volatile("s_waitcnt vmcnt(0)" ::: "memory");
            const unsigned og = xb_add(&bar[XB_TOP], 1u);
            const unsigned tg = og / nx;
            if (og + 1u == (tg + 1u) * nx) xb_add(&bar[XB_TOPGEN], 1u);
            else XB_SPIN(xb_ld(&bar[XB_TOPGEN]) == tg, bar);
            __builtin_amdgcn_fence(__ATOMIC_ACQUIRE, "agent");
            xb_add(&bar[XB_XGEN(b.x)], 1u);
            asm volatile("s_waitcnt vmcnt(0)" ::: "memory");
        } else {
            XB_SPIN(xb_ld(&bar[XB_XGEN(b.x)]) == gen, bar);
            __builtin_amdgcn_fence(__ATOMIC_ACQUIRE, "agent");
            asm volatile("s_waitcnt vmcnt(0)" ::: "memory");
        }
    }
    __syncthreads();
}

__global__ void __launch_bounds__(NTHR, 2) fwd_kernel(Args A) {
    extern __shared__ __attribute__((aligned(16))) unsigned char lds_raw[];
    LAS unsigned char* lds = (LAS unsigned char*)lds_raw;
    cg::grid_group grid = cg::this_grid();
    const int wave_s = __builtin_amdgcn_readfirstlane((int)threadIdx.x >> 6);
    if (threadIdx.x < 32) ((LAS unsigned*)(lds + MISC_OFF))[threadIdx.x] = (threadIdx.x == 16) ? (unsigned)blockIdx.x : 0u;
    __syncthreads();
    (void)xcd_barrier_post((unsigned*)(A.ws + WS_CTL), (volatile LAS unsigned*)(lds + MISC_OFF) + 8);
#define OPQ_PTR(T, member) ({ unsigned long long p_; asm volatile("s_load_dwordx2 %0, %1, %2\n\ts_waitcnt lgkmcnt(0)" : "=s"(p_) : "s"(__builtin_amdgcn_kernarg_segment_ptr()), "i"((int)__builtin_offsetof(Args, member))); (T)p_; })
#define ws OPQ_PTR(unsigned char*, ws)
#define G ((int)gridDim.x)
#define bx ({ int b_; asm volatile("v_mov_b32 %0, %1\n\tds_read_b32 %0, %0\n\ts_waitcnt lgkmcnt(0)" : "=v"(b_) : "i"(MISC_OFF + 64)); __builtin_amdgcn_readfirstlane(b_); })
#define vcu ({ const int b_ = bx; (G % 8 == 0) ? (b_ % 8) * (G / 8) + b_ / 8 : b_; })
#define ngw (G * NWAVES)
#define H ((bf16_t*)(ws + WS_Y))
#define X16 ((bf16_t*)(ws + WS_H))
#define PROJ ((bf16_t*)(ws + WS_PROJ))
#define QM ((bf16_t*)(ws + WS_QM))
#define KVM ((bf16_t*)(ws + WS_KVM))
#define Y ((bf16_t*)(ws + WS_Y))
#define HID ((bf16_t*)(ws + WS_HID))
#define mod ((const float*)(ws + WS_MOD))
#define ropA ((const float*)(ws + WS_ROPA))
#define ropB ((const float*)(ws + WS_ROPB))
#define xres OPQ_PTR(float*, out)
#define XG ((bf16_t*)(ws + WS_XG))
#define SHW ((const float*)(ws + WS_SHW))
#define SSQ(l_, w_) ((pg8::ssq_t*)(ws + WS_SSQ) + ((size_t)(l_) * 8 + (w_)) * MTOK)
    int ph = 0;
#if MK_MULTI
#define PHASE_ON() (ph >= A.ph_lo && ph < A.ph_hi)
#define SEAM() do { if (ph >= A.ph_lo && ph + 1 < A.ph_hi) grid.sync(); ++ph; } while (0)
#else
#define PHASE_ON() (true)
#define SEAM() do { XcdBarrier xb_; xb_.bar = (unsigned*)(ws + WS_CTL); xb_.x = xb_xcc_id(); xb_.st = (volatile LAS unsigned*)(lds + MISC_OFF) + 8; xcd_barrier(xb_); } while (0)
#endif

    if (PHASE_ON() && EN_PRO) prologue(A, lds, vcu, G, wave_s);
    grid.sync();
    shw_tasks(mod, (const bf16_t*)(ws + WS_WIN), (const bf16_t*)(ws + WS_WGU), (float*)(ws + WS_SHW), vcu, ngw, wave_s);
    xg_pass(A.in[0], A.in[5], mod + 1 * DM, XG, X16, SSQ(0, 0), vcu, ngw, wave_s);
    SEAM();
#pragma unroll 1
    for (int l = 0; l < DEPTH; ++l) {
#define modl (mod + (size_t)l * 16 * NMOD)
#define xin ((l == 0) ? A.in[0] : (const float*)xres)
        if (PHASE_ON() && EN_P2) {
            pg8::Gemm g{XG, (const bf16_t*)(ws + WS_WIN) + l * WIN_L, MTOK, PJ, DM, DM}; pg8::StaticOrder S; S.init(MTOK, PJ, G, bx, REP_G2);
            pg8::EpiIn E{PROJ, ropA, ropB, SSQ(l, 0), SHW + (size_t)l * 16 * 7680, SSQ(l, 2), SSQ(l, 3)};
            pg8::gemm_phase<pg8::EpiIn, pg8::StaticOrder, true, true>(lds, g, S, E, wave_s);
        }
        SEAM();
        if (PHASE_ON()) {
            if (EN_P3A) { pg8::Gemm g{PROJ + PC_CQ, (const bf16_t*)(ws + WS_WUQ) + l * WUQ_L, MTOK, 768, 384, PJP}; pg8::StaticOrder S; S.init(MTOK, 768, G, bx, REP_G3);
              pg8::EpiUQ E{QM, SSQ(l, 2), ropB};
              pg8::gemm_phase<pg8::EpiUQ, pg8::StaticOrder, true, true>(lds, g, S, E, wave_s); }
            if (EN_P3B) { pg8::Gemm g{PROJ + PC_CKV, (const bf16_t*)(ws + WS_WUKV) + l * WUKV_L, MTOK, 768, 256, PJP}; pg8::StaticOrder S; S.init(MTOK, 768, G, bx, REP_G3);
              pg8::EpiUKV E{KVM, SSQ(l, 3)};
              pg8::gemm_phase<pg8::EpiUKV, pg8::StaticOrder, true, true>(lds, g, S, E, wave_s); }
            __syncthreads();
            if (EN_P3C) for (int u = vcu; u < NBATCH * 16 * 2; u += G) {
                const int kvh = u & 1, qb = (u >> 1) & 15, b = u >> 5;
                swa_unit3(lds, PROJ + (size_t)b * SEQ * PJP, Y + (size_t)b * SEQ * DM, qb * 256, kvh, A.in[7] + l * 6, SSQ(l, 4) + (size_t)b * SEQ, wave_s);
            }
            if (EN_P3D) for (int u_ = vcu; u_ < REP_SGU * NBATCH * 32; u_ += G) { const int u = u_ % (NBATCH * 32);
                sgu_unit(lds, PROJ, Y, (const bf16_t*)(ws + WS_WS) + l * WS_L, A.in[12] + l * 256, A.in[13] + l * 256, A.in[15] + l * 512, u * 128, SSQ(l, 6), wave_s); }
        }
        SEAM();
        if (PHASE_ON() && EN_P4) {
            for (int u_ = vcu; u_ < REP_P4 * NBATCH * 6 * 8; u_ += G) {
                const int u = u_ % (NBATCH * 6 * 8); const int s = u & 7, bh = u >> 3, b = bh / 6, h = bh % 6;
                const bf16_t* qb_ = QM + (size_t)b * SEQ * QMP + 96 * h;
                const bf16_t* kb_ = KVM + (size_t)b * SEQ * KVP + 128 * h;
                const bf16_t* kr_ = PROJ + (size_t)b * SEQ * PJP + PC_KR;
                bf16_t* ob_ = Y + (size_t)b * SEQ * DM + 384 + 64 * h;
                attn_unit<6, 0>(lds, qb_, QMP, kb_, KVP, kr_, PJP, kb_ + 64, KVP, ob_, DM, (15 - s) * 256, -1e30f, 0.f, (u_ >= NBATCH * 6 * 8 ? SSQ(l, 7) : SSQ(l, 5)) + (size_t)b * SEQ, wave_s);
                attn_unit<6, 0>(lds, qb_, QMP, kb_, KVP, kr_, PJP, kb_ + 64, KVP, ob_, DM, s * 256, -1e30f, 0.f, (u_ >= NBATCH * 6 * 8 ? SSQ(l, 7) : SSQ(l, 5)) + (size_t)b * SEQ, wave_s);
            }
        }
        SEAM();
        if (PHASE_ON() && EN_P6) {
            pg8::Gemm g{Y, (const bf16_t*)(ws + WS_WOUT) + l * WOUT_L, MTOK, DM, DM, DM}; pg8::StaticOrder S; S.init(MTOK, DM, G, bx);
#pragma unroll 1
            for (int rep_ = 0; rep_ < REP_P6; ++rep_) { const bool dmy = rep_ + 1 < REP_P6;
            pg8::EpiRes<true> E{X16, dmy ? PROJ : X16, modl + 2 * DM, dmy ? QM : XG, A.in[18] + l * DM, modl + 4 * DM, dmy ? (pg8::ssq_t*)(ws + 1008 * MiB) : SSQ(l, 1), SSQ(l, 4), SSQ(l, 5), SSQ(l, 6)};
            pg8::gemm_phase<pg8::EpiRes<true>, pg8::StaticOrder, true, true>(lds, g, S, E, wave_s); }
        }
        SEAM();
        if (PHASE_ON() && EN_P8) {
            pg8::Gemm g{XG, (const bf16_t*)(ws + WS_WGU) + l * WGU_L, MTOK, 2 * FFN, DM, DM}; pg8::StaticOrder S; S.init(MTOK, 2 * FFN, G, bx, REP_G8);
            pg8::EpiGU E{HID, SSQ(l, 1), SHW + (size_t)l * 16 * 7680 + PJ};
            pg8::gemm_phase<pg8::EpiGU, pg8::StaticOrder, true, true>(lds, g, S, E, wave_s);
        }
        SEAM();
        if (PHASE_ON() && EN_P9) {
            pg8::Gemm g{HID, (const bf16_t*)(ws + WS_WDN) + l * WDN_L, MTOK, DM, FFN, FFN}; pg8::StaticOrder S; S.init(MTOK, DM, G, bx);
            const int ln = (l + 1 < DEPTH) ? l + 1 : l;
#pragma unroll 1
            for (int rep_ = 0; rep_ < REP_P9; ++rep_) { const bool dmy = rep_ + 1 < REP_P9;
            pg8::EpiRes<false> E{X16, dmy ? Y : X16, modl + 5 * DM, (l + 1 < DEPTH) ? (dmy ? Y : XG) : (bf16_t*)nullptr, A.in[5] + ln * DM, mod + (size_t)ln * 16 * NMOD + 1 * DM, dmy ? SSQ(l, 7) : SSQ(ln, 0), nullptr, nullptr, nullptr};
            pg8::gemm_phase<pg8::EpiRes<false>, pg8::StaticOrder, true, true>(lds, g, S, E, wave_s); }
        }
        SEAM();
    }
    if (PHASE_ON() && EN_FIN) final_norm_pass(X16, xres, A.in[21], vcu, ngw, wave_s);
#undef PHASE_ON
#undef SEAM
#undef ws
#undef G
#undef bx
#undef vcu
#undef ngw
#undef H
#undef PROJ
#undef QM
#undef KVM
#undef Y
#undef HID
#undef mod
#undef ropA
#undef ropB
#undef xres
#undef modl
#undef xin
#undef X16
#undef XG
#undef SHW
#undef SSQ
}

extern "C" void kernel_launch(void* const* d_in, const int* in_sizes, int n_in, void* d_out, int out_size, void* d_ws, size_t ws_size, hipStream_t stream) {
    static int grid = 0;
    if (grid == 0) {
        if (n_in != 22 || out_size != MTOK * DM || ws_size < WS_END) { fprintf(stderr, "kernel_launch: unexpected shapes (n_in %d out %d ws %zu)\n", n_in, out_size, ws_size); grid = -1; return; }
        int dev = 0, cus = 0, per_cu = 0;
        hipGetDevice(&dev); hipDeviceGetAttribute(&cus, hipDeviceAttributeMultiprocessorCount, dev);
        if (hipFuncSetAttribute((const void*)fwd_kernel, hipFuncAttributeMaxDynamicSharedMemorySize, LDS_BYTES) != hipSuccess) { fprintf(stderr, "kernel_launch: hipFuncSetAttribute failed\n"); grid = -1; return; }
        if (hipOccupancyMaxActiveBlocksPerMultiprocessor(&per_cu, (const void*)fwd_kernel, NTHR, LDS_BYTES) != hipSuccess || per_cu < 1) { fprintf(stderr, "kernel_launch: occupancy query says %d\n", per_cu); per_cu = 1; }
        (void)hipGetLastError();
        grid = cus;
    }
    if (grid < 0) return;
    if (hipMemsetAsync((char*)d_ws + WS_CTL, 0, CTL_BYTES, stream) != hipSuccess) { fprintf(stderr, "kernel_launch: memset failed\n"); return; }
    Args a{};
    for (int i = 0; i < 22; ++i) a.in[i] = (const float*)d_in[i];
    a.out = (float*)d_out; a.ws = (unsigned char*)d_ws;
    for (int j = 0; j < 32; ++j) a.inv[j] = (float)(1.0 / pow(10000.0, (double)(2 * j) / 64.0));
    for (int j = 0; j < 16; ++j) a.inv[32 + j] = (float)(1.0 / pow(10000.0, (double)(2 * j) / 32.0));
#if MK_MULTI
    const int nph = 1 + DEPTH * 9 + 1;
    for (int p = 0; p < nph; ++p) { a.ph_lo = p; a.ph_hi = p + 1; hipLaunchKernelGGL(fwd_kernel, dim3(grid), dim3(NTHR), LDS_BYTES, stream, a); }
#else
    a.ph_lo = 0; a.ph_hi = 1 << 20;
    void* args[] = {&a};
    hipError_t e = hipLaunchCooperativeKernel((const void*)fwd_kernel, dim3(grid), dim3(NTHR), args, LDS_BYTES, stream);
    if (e != hipSuccess) fprintf(stderr, "cooperative launch failed: %s (grid %d)\n", hipGetErrorString(e), grid);
#endif
}
```

```cpp
#include <hip/hip_runtime.h>
#include <hip/hip_cooperative_groups.h>
#include <cstdio>
#include <cstdint>
#include <cmath>
namespace cg = cooperative_groups;
#ifndef EN_PRO
#define EN_PRO 1
#endif
#ifndef EN_P1
#define EN_P1 1
#endif
#ifndef EN_P2
#define EN_P2 1
#endif
#ifndef EN_P3A
#define EN_P3A 1
#endif
#ifndef EN_P3B
#define EN_P3B 1
#endif
#ifndef EN_P3C
#define EN_P3C 1
#endif
#ifndef EN_P3D
#define EN_P3D 1
#endif
#ifndef EN_P4
#define EN_P4 1
#endif
#ifndef EN_P5
#define EN_P5 1
#endif
#ifndef EN_P6
#define EN_P6 1
#endif
#ifndef EN_P7
#define EN_P7 1
#endif
#ifndef EN_P8
#define EN_P8 1
#endif
#ifndef EN_P9
#define EN_P9 1
#endif
#ifndef EN_FIN
#define EN_FIN 1
#endif
#ifndef REP_PASS
#define REP_PASS 1
#endif
#ifndef REP_SWA
#define REP_SWA 1
#endif
#ifndef REP_SGU
#define REP_SGU 1
#endif
#ifndef REP_G2
#define REP_G2 1
#endif
#ifndef REP_G3
#define REP_G3 1
#endif
#ifndef REP_G8
#define REP_G8 1
#endif
#ifndef REP_PRO
#define REP_PRO 1
#endif
#ifndef REP_SYNC
#define REP_SYNC 1
#endif
#ifndef REP_P9
#define REP_P9 1
#endif
#ifndef REP_P6
#define REP_P6 1
#endif
#ifndef REP_P4
#define REP_P4 1
#endif
#ifndef MK_MULTI
#define MK_MULTI 0
#endif

#define LAS __attribute__((address_space(3)))
typedef unsigned short bf16_t;
typedef short bf16x8 __attribute__((ext_vector_type(8)));
typedef float f32x4 __attribute__((ext_vector_type(4)));
typedef float f32x2 __attribute__((ext_vector_type(2)));
typedef float f32x16 __attribute__((ext_vector_type(16)));
typedef unsigned u32x4 __attribute__((ext_vector_type(4)));
typedef unsigned u32x2 __attribute__((ext_vector_type(2)));

constexpr int DM = 1024, NBATCH = 16, SEQ = 4096, DEPTH = 4, MTOK = NBATCH * SEQ;
constexpr int INC = 1824, PJ = 2048, FFN = 2816, NMOD = 6 * DM;
constexpr int PJP = PJ + 64;
constexpr int PC_AQ = 0, PC_AK = 384, PC_AV = 512, PC_KR = 640, PC_CQ = 768, PC_CKV = 1152, PC_CU = 1536, PC_CV = 1792;
constexpr int QMP = 768, KVP = 768;
constexpr float EPS = 1e-6f;
constexpr float LOG2E = 1.4426950408889634f;
constexpr float QS_A = 0.125f * LOG2E;
constexpr float QS_B = 0.10206207261596575f * LOG2E;
constexpr int NWAVES = 8, NTHR = 512;
constexpr int LDS_BYTES = 147456;

constexpr size_t MiB = 1u << 20;
constexpr size_t WS_WIN = 0, WS_WUQ = 16 * MiB, WS_WUKV = 19 * MiB, WS_WOUT = 21 * MiB, WS_WGU = 29 * MiB, WS_WDN = 73 * MiB, WS_WS = 95 * MiB;
constexpr size_t WS_MOD = 96 * MiB, WS_ROPA = 98 * MiB, WS_ROPB = 114 * MiB;
constexpr size_t WS_H = 128 * MiB, WS_PROJ = 256 * MiB, WS_QM = 520 * MiB, WS_KVM = 616 * MiB, WS_Y = 712 * MiB, WS_HID = 256 * MiB, WS_CTL = 840 * MiB, WS_SHW = 845 * MiB, WS_XG = 848 * MiB, WS_SSQ = 976 * MiB, WS_END = 1008 * MiB;
constexpr size_t CTL_BYTES = 65536;
constexpr int MISC_OFF = 131072 + 320;
constexpr size_t WIN_L = (size_t)PJ * DM, WUQ_L = (size_t)768 * 384, WUKV_L = (size_t)768 * 256, WOUT_L = (size_t)DM * DM, WGU_L = (size_t)2 * FFN * DM, WDN_L = (size_t)DM * FFN, WS_L = (size_t)4 * 128 * 128;

struct Args {
    const float* in[22];
    float* out; unsigned char* ws;
    float inv[48];
    int ph_lo, ph_hi;
};

__device__ __forceinline__ int opaque_tid(int wave_s) { int l; asm volatile("v_mbcnt_lo_u32_b32 %0, -1, 0\n\tv_mbcnt_hi_u32_b32 %0, -1, %0" : "=v"(l)); return (wave_s << 6) | l; }
__device__ __forceinline__ unsigned cvtpk(float lo, float hi) { unsigned r; asm volatile("v_cvt_pk_bf16_f32 %0, %1, %2" : "=v"(r) : "v"(lo), "v"(hi)); return r; }
__device__ __forceinline__ float bf2f(unsigned short h) { return __uint_as_float(((unsigned)h) << 16); }
__device__ __forceinline__ float bflo(unsigned w) { return __uint_as_float(w << 16); }
__device__ __forceinline__ float bfhi(unsigned w) { return __uint_as_float(w & 0xffff0000u); }
__device__ __forceinline__ float shfl_x(float v, int m, int lane) { return __builtin_bit_cast(float, __builtin_amdgcn_ds_bpermute((lane ^ m) << 2, __builtin_bit_cast(int, v))); }
__device__ __forceinline__ float wave_sum(float v, int lane) {
#pragma unroll
    for (int o = 1; o < 64; o <<= 1) v += shfl_x(v, o, lane);
    return v;
}
__device__ __forceinline__ float silu_f(float v) { return v * __builtin_amdgcn_rcpf(1.f + __builtin_amdgcn_exp2f(-v * LOG2E)); }


namespace pg8 {
#define PG8_LAS __attribute__((address_space(3)))
typedef unsigned short bf16_t;
typedef short bf16x8 __attribute__((ext_vector_type(8)));
typedef float f32x4 __attribute__((ext_vector_type(4)));
typedef unsigned u32x4 __attribute__((ext_vector_type(4)));
constexpr int BM = 256, BK = 64, HALF = 128, HTB = HALF * BK * 2  , STAGE_BYTES = 8 * HTB, NXCD = 8, WGM = 8;

__host__ __device__ __forceinline__ int lds_byte(int r, int c) { const int st = (r >> 4) * 2 + (c >> 5), rr = r & 15, cc = c & 31, ob = rr * 64 + cc * 2; return st * 1024 + (ob ^ (((ob >> 9) & 1) << 5)); }
__host__ __device__ __forceinline__ void stage_rc(int b, int& R, int& C) { const int st = b / 1024, sb = b % 1024, swz = sb ^ (((sb >> 9) & 1) << 5); R = (st >> 1) * 16 + swz / 64; C = (st & 1) * 32 + (swz % 64) / 2; }
__host__ __device__ __forceinline__ int perm32(int rho) { const int n = rho >> 4, i = rho & 15; return 8 * (i >> 2) + 4 * n + (i & 3); }

struct Unit { int pm, pn; };
struct Gemm { const bf16_t* A; const bf16_t* Bt; int M, N, K, lda; };

struct StaticOrder {
    int nM, nN, nwg, G, c, rep;
    __host__ __device__ void init(int M, int N, int G_, int c_, int rep_ = 1) { nM = M / BM; nN = N / BM; nwg = nM * nN; G = G_; c = c_; rep = rep_; }
    __host__ __device__ bool next(int i, Unit& u) const {
        const long L = (long)i * G + c; if (L >= (long)nwg * rep) return false;
        int wgid = (int)(L % nwg); { const int q = nwg / NXCD, r = nwg % NXCD, xcd = wgid % NXCD, off = wgid / NXCD; wgid = (xcd < r ? xcd * (q + 1) : r * (q + 1) + (xcd - r) * q) + off; }
        const int nig = WGM * nN, gid = wgid / nig, fm = gid * WGM, gsz = (nM - fm) < WGM ? (nM - fm) : WGM;
        u.pm = fm + ((wgid % nig) % gsz); u.pn = (wgid % nig) / gsz; return true;
    }
    __device__ __forceinline__ void a_ready(const Unit&) const {}
    __device__ __forceinline__ void done(const Unit&) const {}
};

__device__ __forceinline__ unsigned cvt_pk_bf16(float lo, float hi) { unsigned r; asm volatile("v_cvt_pk_bf16_f32 %0, %1, %2" : "=v"(r) : "v"(lo), "v"(hi)); return r; }
typedef float f32x2 __attribute__((ext_vector_type(2)));
__device__ __forceinline__ f32x2 gelu_pk(f32x2 v) {
    const f32x2 av = __builtin_elementwise_abs(v), d = av * 0.2316418882f + 1.0f;
    f32x2 t; t.x = __builtin_amdgcn_rcpf(d.x); t.y = __builtin_amdgcn_rcpf(d.y);
    f32x2 q = t * 0.5307027145f + (-0.7265760135f); q = q * t + 0.7107068705f; q = q * t + (-0.142248368f); q = q * t + 0.127414796f; q = q * t;
    const f32x2 s = (v * v) * (-0.72134752044f);
    f32x2 e; e.x = __builtin_amdgcn_exp2f(s.x); e.y = __builtin_amdgcn_exp2f(s.y);
    const f32x2 m = v * (q * e), r = v - m;
    f32x2 o; o.x = v.x < 0.f ? m.x : r.x; o.y = v.y < 0.f ? m.y : r.y; return o;
}

template <class Epi, class Sched, bool ALIGN_EPI = false, bool SP2 = false>
__device__ __forceinline__ void gemm_phase(PG8_LAS unsigned char* lds, const Gemm g, const Sched& S, const Epi& E, const int wave_s) {
    const int tid = opaque_tid(wave_s), wid = __builtin_amdgcn_readfirstlane(tid >> 6), lane = tid & 63, wr = wid >> 2, wc = wid & 3, fr = lane & 15, fq = lane >> 4;
    const int K = g.K, nt = K / BK;
    unsigned voffA[2], voffB[2];
#pragma unroll
    for (int i = 0; i < 2; ++i) { int R, C; stage_rc(tid * 16 + i * 8192, R, C); const int Rb = Epi::PERM ? ((R & ~31) + perm32(R & 31)) : R;
        voffA[i] = (unsigned)(R * g.lda + C) * 2u; voffB[i] = (unsigned)(Rb * K + C) * 2u; }
    const size_t kstep = (size_t)(BK * 2);
    const size_t hstepA = (size_t)HALF * g.lda * 2, hstepB = (size_t)HALF * K * 2;
    const size_t tstepA = 2 * hstepA, tstepB = 2 * hstepB;
    const unsigned ldsw = (unsigned)wid * 1024u;
    const int aoff = lds_byte(wr * 64 + fr, fq * 8), boff = lds_byte(wc * 32 + fr, fq * 8);
#define PG8_SA(b, h) (((b) * 2 + (h)) * HTB)
#define PG8_SB(b, h) ((4 + (b) * 2 + (h)) * HTB)
#define PG8_STAGE(bufoff, gbase, voff) do { _Pragma("unroll") for (int _i = 0; _i < 2; ++_i) \
        __builtin_amdgcn_global_load_lds((const unsigned*)((const char*)(gbase) + (voff)[_i]), (PG8_LAS unsigned*)(lds + (bufoff) + ldsw + _i * 8192), 16, 0, 0); } while (0)
#define PG8_LDA(dst, b, h) do { _Pragma("unroll") for (int m = 0; m < 4; ++m) _Pragma("unroll") for (int k = 0; k < 2; ++k) dst[m][k] = *(const PG8_LAS bf16x8*)(lds + PG8_SA(b, h) + aoff + m * 2048 + k * 1024); } while (0)
#define PG8_LDB(dst, b, h) do { _Pragma("unroll") for (int n = 0; n < 2; ++n) _Pragma("unroll") for (int k = 0; k < 2; ++k) dst[n][k] = *(const PG8_LAS bf16x8*)(lds + PG8_SB(b, h) + boff + n * 2048 + k * 1024); } while (0)
#define PG8_MMA(ai, bj, At, Bt) do { __builtin_amdgcn_s_setprio(1); _Pragma("unroll") for (int m = 0; m < 4; ++m) _Pragma("unroll") for (int n = 0; n < 2; ++n) _Pragma("unroll") for (int k = 0; k < 2; ++k) \
        acc[ai][bj][m][n] = __builtin_amdgcn_mfma_f32_16x16x32_bf16(Bt[n][k], At[m][k], acc[ai][bj][m][n], 0, 0, 0); __builtin_amdgcn_s_setprio(0); } while (0)
#define PG8_WAIT_V(n) asm volatile("s_waitcnt vmcnt(" #n ")" ::: "memory")
#define PG8_WAIT_L(n) asm volatile("s_waitcnt lgkmcnt(" #n ")" ::: "memory")
#define PG8_BAR __builtin_amdgcn_s_barrier()
#define PG8_SCHED __builtin_amdgcn_sched_barrier(0)
    Unit cur, nxt; int ui = 0;
    if (!S.next(0, cur)) return;
    if constexpr (Epi::KHOOK || Epi::PREF) E.prefetch(cur, 0, lds, opaque_tid(wave_s));
    f32x4 acc[2][2][4][2];
#pragma unroll
    for (int a = 0; a < 2; ++a)
#pragma unroll
        for (int b = 0; b < 2; ++b)
#pragma unroll
            for (int m = 0; m < 4; ++m)
#pragma unroll
                for (int n = 0; n < 2; ++n) acc[a][b][m][n] = (f32x4){0.f, 0.f, 0.f, 0.f};
    bf16x8 At[4][2], B0[2][2], B1[2][2];
    const char* cA = (const char*)g.A + (size_t)cur.pm * tstepA; const char* cB = (const char*)g.Bt + (size_t)cur.pn * tstepB;
    S.a_ready(cur);
    if constexpr (SP2) {
        PG8_STAGE(PG8_SB(0, 0), cB, voffB); PG8_STAGE(PG8_SB(0, 1), cB + hstepB, voffB); PG8_STAGE(PG8_SA(0, 0), cA, voffA); PG8_STAGE(PG8_SA(0, 1), cA + hstepA, voffA);
        if (wr == 1) PG8_BAR;
        PG8_WAIT_V(2); PG8_BAR;
        PG8_STAGE(PG8_SB(1, 0), cB + kstep, voffB); PG8_STAGE(PG8_SA(1, 0), cA + kstep, voffA); PG8_STAGE(PG8_SB(1, 1), cB + hstepB + kstep, voffB);
        PG8_WAIT_V(6); PG8_BAR;
    } else {
        PG8_STAGE(PG8_SB(0, 0), cB, voffB); PG8_STAGE(PG8_SA(0, 0), cA, voffA); PG8_STAGE(PG8_SB(0, 1), cB + hstepB, voffB); PG8_STAGE(PG8_SA(0, 1), cA + hstepA, voffA);
        if (wr == 1) PG8_BAR;
        PG8_WAIT_V(4); PG8_BAR;
        PG8_STAGE(PG8_SB(1, 0), cB + kstep, voffB); PG8_STAGE(PG8_SA(1, 0), cA + kstep, voffA); PG8_STAGE(PG8_SB(1, 1), cB + hstepB + kstep, voffB);
        PG8_WAIT_V(6); PG8_BAR;
    }
    for (;;) {
        const bool has_next = S.next(ui + 1, nxt);
        const char* nA = has_next ? (const char*)g.A + (size_t)nxt.pm * tstepA : cA; const char* nB = has_next ? (const char*)g.Bt + (size_t)nxt.pn * tstepB : cB;
        for (int t = 0; t < nt; t += 2) {
            if constexpr (Epi::KHOOK) { if (t == 6 || t == 12) { const int l3_ = opaque_tid(wave_s) & 63; E.khook(acc, t, wr, l3_ & 15, ui & 1, lds); } }
            const bool last = (t == nt - 2);
            const char* a1 = cA + (size_t)(t + 1) * kstep;
            const char* a2 = last ? nA : cA + (size_t)(t + 2) * kstep; const char* b2 = last ? nB : cB + (size_t)(t + 2) * kstep;
            const char* a3 = a2 + kstep; const char* b3 = b2 + kstep;
            if (last && has_next) S.a_ready(nxt);
            if constexpr (SP2) {
            PG8_LDB(B0, 0, 0); PG8_LDB(B1, 0, 1); PG8_SCHED; PG8_LDA(At, 0, 0); PG8_STAGE(PG8_SA(1, 1), a1 + hstepA, voffA);
            PG8_WAIT_V(8); PG8_WAIT_L(0); PG8_BAR; PG8_MMA(0, 0, At, B0); PG8_MMA(0, 1, At, B1); PG8_BAR; PG8_SCHED;
            PG8_LDA(At, 0, 1); PG8_STAGE(PG8_SB(0, 0), b2, voffB); PG8_STAGE(PG8_SB(0, 1), b2 + hstepB, voffB); PG8_STAGE(PG8_SA(0, 0), a2, voffA);
            PG8_WAIT_V(8); PG8_WAIT_L(0); PG8_BAR; PG8_MMA(1, 0, At, B0); PG8_MMA(1, 1, At, B1); PG8_BAR; PG8_SCHED;
            PG8_LDB(B0, 1, 0); PG8_LDB(B1, 1, 1); PG8_SCHED; PG8_LDA(At, 1, 0); PG8_STAGE(PG8_SA(0, 1), a2 + hstepA, voffA);
            PG8_WAIT_V(8); PG8_WAIT_L(0); PG8_BAR; PG8_MMA(0, 0, At, B0); PG8_MMA(0, 1, At, B1); PG8_BAR; PG8_SCHED;
            PG8_LDA(At, 1, 1); PG8_STAGE(PG8_SB(1, 0), b3, voffB); PG8_STAGE(PG8_SB(1, 1), b3 + hstepB, voffB); PG8_STAGE(PG8_SA(1, 0), a3, voffA);
            PG8_WAIT_V(8); PG8_WAIT_L(0); PG8_BAR; PG8_MMA(1, 0, At, B0); PG8_MMA(1, 1, At, B1); PG8_BAR; PG8_SCHED;
            } else {
            PG8_LDB(B0, 0, 0); PG8_SCHED; PG8_LDA(At, 0, 0); PG8_STAGE(PG8_SA(1, 1), a1 + hstepA, voffA);
            PG8_WAIT_L(8); PG8_BAR; PG8_WAIT_L(0); PG8_MMA(0, 0, At, B0); PG8_BAR; PG8_SCHED;
            PG8_LDB(B1, 0, 1); PG8_STAGE(PG8_SB(0, 0), b2, voffB);
            PG8_BAR; PG8_WAIT_L(0); PG8_MMA(0, 1, At, B1); PG8_BAR;
            PG8_LDA(At, 0, 1); PG8_STAGE(PG8_SA(0, 0), a2, voffA);
            PG8_BAR; PG8_WAIT_L(0); PG8_MMA(1, 0, At, B0); PG8_BAR; PG8_SCHED;
            PG8_STAGE(PG8_SB(0, 1), b2 + hstepB, voffB);
            PG8_WAIT_V(6); PG8_BAR; PG8_MMA(1, 1, At, B1); PG8_BAR;
            PG8_LDB(B0, 1, 0); PG8_SCHED; PG8_LDA(At, 1, 0); PG8_STAGE(PG8_SA(0, 1), a2 + hstepA, voffA);
            PG8_WAIT_L(8); PG8_BAR; PG8_WAIT_L(0); PG8_MMA(0, 0, At, B0); PG8_BAR; PG8_SCHED;
            PG8_LDB(B1, 1, 1); PG8_STAGE(PG8_SB(1, 0), b3, voffB);
            PG8_BAR; PG8_WAIT_L(0); PG8_MMA(0, 1, At, B1); PG8_BAR;
            PG8_LDA(At, 1, 1); PG8_STAGE(PG8_SA(1, 0), a3, voffA);
            PG8_BAR; PG8_WAIT_L(0); PG8_MMA(1, 0, At, B0); PG8_BAR; PG8_SCHED;
            PG8_STAGE(PG8_SB(1, 1), b3 + hstepB, voffB);
            PG8_WAIT_V(6); PG8_BAR; PG8_MMA(1, 1, At, B1); PG8_BAR;
            }
        }
        if constexpr (ALIGN_EPI) { if (wr == 0) PG8_BAR; }
        if constexpr (Epi::KHOOK || Epi::PREF) { if (has_next) E.prefetch(nxt, (ui + 1) & 1, lds, opaque_tid(wave_s)); }
        if constexpr (!Epi::AFTER_DRAIN) { const int l2_ = opaque_tid(wave_s) & 63;
            if constexpr (Epi::PREF) E(acc, cur, wr, wc, l2_ & 15, l2_ >> 4, ui & 1, lds); else E(acc, cur, wr, wc, l2_ & 15, l2_ >> 4);
            S.done(cur); }
        if (!has_next) break;
#pragma unroll
        for (int a = 0; a < 2; ++a)
#pragma unroll
            for (int b = 0; b < 2; ++b)
#pragma unroll
                for (int m = 0; m < 4; ++m)
#pragma unroll
                    for (int n = 0; n < 2; ++n) acc[a][b][m][n] = (f32x4){0.f, 0.f, 0.f, 0.f};
        cur = nxt; cA = nA; cB = nB; ++ui;
        if constexpr (ALIGN_EPI) { if (wr == 1) PG8_BAR; }
    }
    PG8_WAIT_V(0);
    if constexpr (!ALIGN_EPI) { if (wr == 0) PG8_BAR; }
    PG8_BAR;
    if constexpr (Epi::AFTER_DRAIN) { E.fused(acc, cur, wr, wc, fr, fq, lds, wid, lane); S.done(cur); }
#undef PG8_SA
#undef PG8_SB
#undef PG8_STAGE
#undef PG8_LDA
#undef PG8_LDB
#undef PG8_MMA
#undef PG8_WAIT_V
#undef PG8_WAIT_L
#undef PG8_BAR
#undef PG8_SCHED
}
}

namespace pg8 {
__device__ __forceinline__ f32x2 swiglu_pk(f32x2 g, f32x2 u) {
    const f32x2 t = g * (-LOG2E); f32x2 e; e.x = __builtin_amdgcn_exp2f(t.x); e.y = __builtin_amdgcn_exp2f(t.y);
    const f32x2 d = e + 1.0f; f32x2 r; r.x = __builtin_amdgcn_rcpf(d.x); r.y = __builtin_amdgcn_rcpf(d.y);
    return (g * r) * u;
}
typedef unsigned long long ssq_t;
constexpr float SSQ_FX = 16777216.0f, SSQ_IFX = 1.0f / 16777216.0f;
__device__ __forceinline__ void ssq_put(ssq_t* p, int row, float q, int fr, int fq) {
    const int lane = fr + 16 * fq;
    q += shfl_x(q, 16, lane); q += shfl_x(q, 32, lane);
    if (fq == 0) __hip_atomic_fetch_add(p + row, (ssq_t)(q * SSQ_FX), __ATOMIC_RELAXED, __HIP_MEMORY_SCOPE_AGENT);
}
__device__ __forceinline__ float ssq_val(ssq_t v) { return (float)v * SSQ_IFX; }
struct EpiIn {
    static constexpr bool PERM = true, AFTER_DRAIN = false, KHOOK = false, PREF = false;
    bf16_t* O; const float* ropA; const float* ropB; const ssq_t* ssqx; const float* shw; ssq_t* ssq_cq; ssq_t* ssq_ckv;
    __device__ __forceinline__ void operator()(const f32x4 (&acc)[2][2][4][2], const Unit& u, int wr, int wc, int fr, int fq) const {
        const int row0 = u.pm * BM + wr * 64 + fr; const int b = (u.pm * BM) >> 12;
        ssq_t sv[8]; float rsv[8];
#pragma unroll
        for (int i = 0; i < 8; ++i) sv[i] = ssqx[row0 + (i >> 2) * HALF + (i & 3) * 16];
#pragma unroll
        for (int i = 0; i < 8; ++i) rsv[i] = 1.0f / sqrtf(ssq_val(sv[i]) * (1.0f / DM) + EPS);
#pragma unroll
        for (int bj = 0; bj < 2; ++bj) {
            const int colw = u.pn * BM + bj * HALF + wc * 32, col0 = colw + 8 * fq;
            const int mode = colw < 512 ? 1 : (colw < 640 ? 0 : (colw < 672 ? 2 : (colw < 1536 ? 0 : 3)));
            const int stat = (colw >= PC_CQ && colw < PC_CKV) ? 1 : ((colw >= PC_CKV && colw < PC_CKV + 256) ? 2 : 0);
            const float sc = colw < 384 ? QS_A : 1.f;
            const f32x4 s0 = *(const f32x4*)(shw + (size_t)b * 7680 + col0), s1 = *(const f32x4*)(shw + (size_t)b * 7680 + col0 + 4);
#pragma unroll
            for (int ai = 0; ai < 2; ++ai)
#pragma unroll
                for (int m = 0; m < 4; ++m) {
                    const int row = row0 + ai * HALF + m * 16;
                    const float rs = rsv[ai * 4 + m];
                    f32x4 v0 = acc[ai][bj][m][0] * rs + s0, v1 = acc[ai][bj][m][1] * rs + s1;
                    if (mode == 1 || mode == 2) {
                        const float* tp = (mode == 1) ? (ropA + ((size_t)row * 32 + ((col0 & 63) >> 1)) * 2) : (ropB + ((size_t)row * 16 + ((col0 - PC_KR) >> 1)) * 2);
                        const f32x4 c0 = *(const f32x4*)tp, c1 = *(const f32x4*)(tp + 4);
                        f32x4 w0, w1;
                        w0[0] = v0[0] * c0[0] - v0[1] * c0[1]; w0[1] = v0[1] * c0[0] + v0[0] * c0[1];
                        w0[2] = v0[2] * c0[2] - v0[3] * c0[3]; w0[3] = v0[3] * c0[2] + v0[2] * c0[3];
                        w1[0] = v1[0] * c1[0] - v1[1] * c1[1]; w1[1] = v1[1] * c1[0] + v1[0] * c1[1];
                        w1[2] = v1[2] * c1[2] - v1[3] * c1[3]; w1[3] = v1[3] * c1[2] + v1[2] * c1[3];
                        v0 = w0 * sc; v1 = w1 * sc;
                    } else if (mode == 3) {
                        const f32x2 a = gelu_pk((f32x2){v0[0], v0[1]}), bb = gelu_pk((f32x2){v0[2], v0[3]}), c = gelu_pk((f32x2){v1[0], v1[1]}), d = gelu_pk((f32x2){v1[2], v1[3]});
                        v0 = (f32x4){a.x, a.y, bb.x, bb.y}; v1 = (f32x4){c.x, c.y, d.x, d.y};
                    }
                    if (stat) {
                        const float q = (v0[0] * v0[0] + v0[1] * v0[1]) + (v0[2] * v0[2] + v0[3] * v0[3]) + (v1[0] * v1[0] + v1[1] * v1[1]) + (v1[2] * v1[2] + v1[3] * v1[3]);
                        ssq_put(stat == 1 ? ssq_cq : ssq_ckv, row, q, fr, fq);
                    }
                    u32x4 w; w.x = cvt_pk_bf16(v0[0], v0[1]); w.y = cvt_pk_bf16(v0[2], v0[3]); w.z = cvt_pk_bf16(v1[0], v1[1]); w.w = cvt_pk_bf16(v1[2], v1[3]);
                    *(u32x4*)(O + (size_t)row * PJP + col0) = w;
                }
        }
    }
};
struct EpiUQ {
    static constexpr bool PERM = true, AFTER_DRAIN = false, KHOOK = false, PREF = false;
    bf16_t* O; const ssq_t* ssq; const float* ropB;
    __device__ __forceinline__ void operator()(const f32x4 (&acc)[2][2][4][2], const Unit& u, int wr, int wc, int fr, int fq) const {
        const int row0 = u.pm * BM + wr * 64 + fr;
        ssq_t sv[8]; float rsv[8];
#pragma unroll
        for (int i = 0; i < 8; ++i) sv[i] = ssq[row0 + (i >> 2) * HALF + (i & 3) * 16];
#pragma unroll
        for (int i = 0; i < 8; ++i) rsv[i] = QS_B / sqrtf(ssq_val(sv[i]) * (1.0f / 384.0f) + EPS);
#pragma unroll
        for (int ai = 0; ai < 2; ++ai)
#pragma unroll
            for (int m = 0; m < 4; ++m) {
                const int row = row0 + ai * HALF + m * 16;
                const float rs = rsv[ai * 4 + m];
#pragma unroll
                for (int bj = 0; bj < 2; ++bj) {
                    const int colw = u.pn * BM + bj * HALF + wc * 32, col0 = colw + 8 * fq;
                    const bool rope = (colw % 96) == 64 && colw < 576;
                    f32x4 v0 = acc[ai][bj][m][0] * rs, v1 = acc[ai][bj][m][1] * rs;
                    if (rope) {
                        const float* tp = ropB + ((size_t)row * 16 + ((col0 - colw) >> 1)) * 2;
                        const f32x4 c0 = *(const f32x4*)tp, c1 = *(const f32x4*)(tp + 4);
                        f32x4 w0, w1;
                        w0[0] = v0[0] * c0[0] - v0[1] * c0[1]; w0[1] = v0[1] * c0[0] + v0[0] * c0[1];
                        w0[2] = v0[2] * c0[2] - v0[3] * c0[3]; w0[3] = v0[3] * c0[2] + v0[2] * c0[3];
                        w1[0] = v1[0] * c1[0] - v1[1] * c1[1]; w1[1] = v1[1] * c1[0] + v1[0] * c1[1];
                        w1[2] = v1[2] * c1[2] - v1[3] * c1[3]; w1[3] = v1[3] * c1[2] + v1[2] * c1[3];
                        v0 = w0; v1 = w1;
                    }
                    u32x4 w; w.x = cvt_pk_bf16(v0[0], v0[1]); w.y = cvt_pk_bf16(v0[2], v0[3]); w.z = cvt_pk_bf16(v1[0], v1[1]); w.w = cvt_pk_bf16(v1[2], v1[3]);
                    *(u32x4*)(O + (size_t)row * QMP + col0) = w;
                }
            }
    }
};
struct EpiUKV {
    static constexpr bool PERM = true, AFTER_DRAIN = false, KHOOK = false, PREF = false;
    bf16_t* O; const ssq_t* ssq;
    __device__ __forceinline__ void operator()(const f32x4 (&acc)[2][2][4][2], const Unit& u, int wr, int wc, int fr, int fq) const {
        const int row0 = u.pm * BM + wr * 64 + fr;
        ssq_t sv[8]; float rsv[8];
#pragma unroll
        for (int i = 0; i < 8; ++i) sv[i] = ssq[row0 + (i >> 2) * HALF + (i & 3) * 16];
#pragma unroll
        for (int i = 0; i < 8; ++i) rsv[i] = 1.0f / sqrtf(ssq_val(sv[i]) * (1.0f / 256.0f) + EPS);
#pragma unroll
        for (int ai = 0; ai < 2; ++ai)
#pragma unroll
            for (int m = 0; m < 4; ++m) {
                const int row = row0 + ai * HALF + m * 16;
                const float rs = rsv[ai * 4 + m];
#pragma unroll
                for (int bj = 0; bj < 2; ++bj) {
                    const int col0 = u.pn * BM + bj * HALF + wc * 32 + 8 * fq;
                    const f32x4 v0 = acc[ai][bj][m][0] * rs, v1 = acc[ai][bj][m][1] * rs;
                    u32x4 w; w.x = cvt_pk_bf16(v0[0], v0[1]); w.y = cvt_pk_bf16(v0[2], v0[3]); w.z = cvt_pk_bf16(v1[0], v1[1]); w.w = cvt_pk_bf16(v1[2], v1[3]);
                    *(u32x4*)(O + (size_t)row * KVP + col0) = w;
                }
            }
    }
};
template <bool GN> struct EpiRes {
    static constexpr bool PERM = true, AFTER_DRAIN = false, KHOOK = GN, PREF = false;
    const bf16_t* base; bf16_t* out; const float* gate; bf16_t* xg; const float* nw; const float* sc; ssq_t* ssq; const ssq_t* gsa; const ssq_t* gsb; const ssq_t* gsc;
    __device__ __forceinline__ void prefetch(const Unit& u, int par, PG8_LAS unsigned char* lds, int tid) const {
        if (tid < BM) {
            const int row = u.pm * BM + tid;
            const float sa = ssq_val(gsa[row]) * (1.0f / 384.0f) + EPS, sb = ssq_val(gsb[row]) * (1.0f / 384.0f) + EPS, sc_ = ssq_val(gsc[row]) * (1.0f / 256.0f) + EPS;
            PG8_LAS float* rp = (PG8_LAS float*)(lds + STAGE_BYTES + 1024) + par * 512;
            rp[tid] = sqrtf(sb / sa); rp[256 + tid] = sqrtf(sc_ / sb);
        }
    }
    __device__ __forceinline__ void khook(f32x4 (&acc)[2][2][4][2], int t, int wr, int fr, int par, PG8_LAS unsigned char* lds) const {
        const PG8_LAS float* rp = (const PG8_LAS float*)(lds + STAGE_BYTES + 1024) + par * 512 + (t == 6 ? 0 : 256) + wr * 64 + fr;
#pragma unroll
        for (int i = 0; i < 8; ++i) {
            const float r = rp[(i >> 2) * HALF + (i & 3) * 16];
#pragma unroll
            for (int bj = 0; bj < 2; ++bj)
#pragma unroll
                for (int n = 0; n < 2; ++n) acc[i >> 2][bj][i & 3][n] *= r;
        }
    }
    __device__ __forceinline__ void operator()(const f32x4 (&acc)[2][2][4][2], const Unit& u, int wr, int wc, int fr, int fq) const {
        float rc[8];
        if constexpr (GN) { ssq_t sc_[8];
#pragma unroll
            for (int i = 0; i < 8; ++i) sc_[i] = gsc[u.pm * BM + wr * 64 + fr + (i >> 2) * HALF + (i & 3) * 16];
#pragma unroll
            for (int i = 0; i < 8; ++i) rc[i] = 1.0f / sqrtf(ssq_val(sc_[i]) * (1.0f / 256.0f) + EPS); }
        const int col0 = u.pn * BM + wc * 32 + 8 * fq; const int b = (u.pm * BM) >> 12;
        const float* gp = gate + (size_t)b * NMOD + col0; const float* sp = sc + (size_t)b * NMOD + col0;
        f32x4 g[2][2], cf[2][2];
#pragma unroll
        for (int bj = 0; bj < 2; ++bj) {
            g[bj][0] = *(const f32x4*)(gp + bj * HALF); g[bj][1] = *(const f32x4*)(gp + bj * HALF + 4);
            const f32x4 n0 = *(const f32x4*)(nw + col0 + bj * HALF), n1 = *(const f32x4*)(nw + col0 + bj * HALF + 4);
            const f32x4 c0 = *(const f32x4*)(sp + bj * HALF), c1 = *(const f32x4*)(sp + bj * HALF + 4);
            cf[bj][0] = n0 * (c0 + 1.0f); cf[bj][1] = n1 * (c1 + 1.0f);
        }
#pragma unroll
        for (int ai = 0; ai < 2; ++ai)
#pragma unroll
        for (int mp = 0; mp < 4; mp += 2) {
            u32x4 bv[2][2];
#pragma unroll
            for (int mm = 0; mm < 2; ++mm)
#pragma unroll
                for (int bj = 0; bj < 2; ++bj)
                    bv[mm][bj] = *(const u32x4*)(base + (size_t)(u.pm * BM + ai * HALF + wr * 64 + (mp + mm) * 16 + fr) * DM + col0 + bj * HALF);
#pragma unroll
            for (int mm = 0; mm < 2; ++mm) {
                const int m = mp + mm;
                const int row = u.pm * BM + ai * HALF + wr * 64 + m * 16 + fr; float q = 0.f;
#pragma unroll
                for (int bj = 0; bj < 2; ++bj) {
                    const size_t off = (size_t)row * DM + col0 + bj * HALF;
                    const u32x4 bw = bv[mm][bj];
                    const f32x4 b0 = (f32x4){__uint_as_float(bw.x << 16), __uint_as_float(bw.x & 0xffff0000u), __uint_as_float(bw.y << 16), __uint_as_float(bw.y & 0xffff0000u)};
                    const f32x4 b1 = (f32x4){__uint_as_float(bw.z << 16), __uint_as_float(bw.z & 0xffff0000u), __uint_as_float(bw.w << 16), __uint_as_float(bw.w & 0xffff0000u)};
                    f32x4 a0 = acc[ai][bj][m][0], a1 = acc[ai][bj][m][1]; if constexpr (GN) { a0 *= rc[ai * 4 + m]; a1 *= rc[ai * 4 + m]; }
                    const f32x4 o0 = b0 + g[bj][0] * a0, o1 = b1 + g[bj][1] * a1;
                    u32x4 wo; wo.x = cvt_pk_bf16(o0[0], o0[1]); wo.y = cvt_pk_bf16(o0[2], o0[3]); wo.z = cvt_pk_bf16(o1[0], o1[1]); wo.w = cvt_pk_bf16(o1[2], o1[3]);
                    *(u32x4*)(out + off) = wo;
                    if (xg) {
                        const f32x4 h0 = o0 * cf[bj][0], h1 = o1 * cf[bj][1];
                        u32x4 w; w.x = cvt_pk_bf16(h0[0], h0[1]); w.y = cvt_pk_bf16(h0[2], h0[3]); w.z = cvt_pk_bf16(h1[0], h1[1]); w.w = cvt_pk_bf16(h1[2], h1[3]);
                        *(u32x4*)(xg + off) = w;
                        q += (o0[0] * o0[0] + o0[1] * o0[1]) + (o0[2] * o0[2] + o0[3] * o0[3]) + (o1[0] * o1[0] + o1[1] * o1[1]) + (o1[2] * o1[2] + o1[3] * o1[3]);
                    }
                }
                if (xg) ssq_put(ssq, row, q, fr, fq);
            }
        }
    }
};
struct EpiGU {
    static constexpr bool PERM = true, AFTER_DRAIN = false, KHOOK = false, PREF = true;
    bf16_t* O; const ssq_t* ssqx; const float* shw;
    __device__ __forceinline__ void prefetch(const Unit& u, int par, PG8_LAS unsigned char* lds, int tid) const {
        PG8_LAS float* rp = (PG8_LAS float*)(lds + STAGE_BYTES + 5120) + par * 512;
        if (tid < BM) rp[tid] = 1.0f / sqrtf(ssq_val(ssqx[u.pm * BM + tid]) * (1.0f / DM) + EPS);
        else rp[tid] = shw[(size_t)((u.pm * BM) >> 12) * 7680 + u.pn * BM + (tid - BM)];
    }
    __device__ __forceinline__ void operator()(const f32x4 (&acc)[2][2][4][2], const Unit& u, int wr, int wc, int fr, int fq, int par, PG8_LAS unsigned char* lds) const {
        const int row0 = u.pm * BM + wr * 64 + fr, col0 = u.pn * HALF + wc * 32 + 8 * fq;
        const PG8_LAS float* rp = (const PG8_LAS float*)(lds + STAGE_BYTES + 5120) + par * 512;
        const PG8_LAS float* sp = rp + 256 + wc * 32 + 8 * fq;
        const f32x4 sg0 = *(const PG8_LAS f32x4*)sp, sg1 = *(const PG8_LAS f32x4*)(sp + 4), su0 = *(const PG8_LAS f32x4*)(sp + HALF), su1 = *(const PG8_LAS f32x4*)(sp + HALF + 4);
        float rsv[8];
#pragma unroll
        for (int i = 0; i < 8; ++i) rsv[i] = rp[(i >> 2) * HALF + wr * 64 + (i & 3) * 16 + fr];
#pragma unroll
        for (int ai = 0; ai < 2; ++ai)
#pragma unroll
            for (int m = 0; m < 4; ++m) {
                const int row = row0 + ai * HALF + m * 16;
                const float rs = rsv[ai * 4 + m];
                const f32x4 g0 = acc[ai][0][m][0] * rs + sg0, g1 = acc[ai][0][m][1] * rs + sg1, u0 = acc[ai][1][m][0] * rs + su0, u1 = acc[ai][1][m][1] * rs + su1;
                f32x4 h0, h1;
                { const f32x2 a = swiglu_pk((f32x2){g0[0], g0[1]}, (f32x2){u0[0], u0[1]}), b2 = swiglu_pk((f32x2){g0[2], g0[3]}, (f32x2){u0[2], u0[3]});
                  const f32x2 c = swiglu_pk((f32x2){g1[0], g1[1]}, (f32x2){u1[0], u1[1]}), d = swiglu_pk((f32x2){g1[2], g1[3]}, (f32x2){u1[2], u1[3]});
                  h0 = (f32x4){a.x, a.y, b2.x, b2.y}; h1 = (f32x4){c.x, c.y, d.x, d.y}; }
                u32x4 w; w.x = cvt_pk_bf16(h0[0], h0[1]); w.y = cvt_pk_bf16(h0[2], h0[3]); w.z = cvt_pk_bf16(h1[0], h1[1]); w.w = cvt_pk_bf16(h1[2], h1[3]);
                *(u32x4*)(O + (size_t)row * FFN + col0) = w;
            }
    }
};
}

constexpr int KSTR = 104, VSTR = 72, ABUF = 64 * KSTR * 2 + 64 * VSTR * 2;
__device__ __forceinline__ int crow(int r, int hi) { return (r & 3) + 8 * (r >> 2) + 4 * hi; }
typedef __attribute__((address_space(1))) const u32x4 g_u32x4;
typedef __attribute__((address_space(1))) const bf16x8 g_bf16x8;
typedef float f32x2_cv __attribute__((ext_vector_type(2))); typedef __bf16 bf16x2_cv __attribute__((ext_vector_type(2)));
__device__ __forceinline__ unsigned cvtpk_s(float lo, float hi) { f32x2_cv v = {lo, hi}; bf16x2_cv b = __builtin_convertvector(v, bf16x2_cv); return __builtin_bit_cast(unsigned, b); }
__device__ __forceinline__ float max3f(float a, float b, float c) { float r; asm("v_max3_f32 %0, %1, %2, %3" : "=v"(r) : "v"(a), "v"(b), "v"(c)); return r; }
constexpr float RESC_THR = 8.0f;
constexpr int ABUF2 = 2 * ABUF;
template <int NDS, int MODE>
__device__ __forceinline__ void attn_unit(LAS unsigned char* lds, const bf16_t* Q, int qp, const bf16_t* K, int kp, const bf16_t* KR, int krp, const bf16_t* V, int vp,
                                          bf16_t* O, int op, int q0, float m_init, float l_init, unsigned long long* gss  , const int wave_s) {
    const int tid = opaque_tid(wave_s), lane = tid & 63, wid = __builtin_amdgcn_readfirstlane(tid >> 6), r32 = lane & 31, hi = lane >> 5;
    const int qw0 = q0 + 32 * wid;
    if (wid < 4) __builtin_amdgcn_s_setprio(1); else __builtin_amdgcn_s_setprio(0);
    bf16x8 qr[NDS];
    { const bf16_t* qrow = Q + (size_t)(qw0 + r32) * qp + 8 * hi;
#pragma unroll
      for (int d0 = 0; d0 < NDS; ++d0) qr[d0] = *(g_bf16x8*)(qrow + 16 * d0); }
    const int tp0 = (MODE == 1) ? ((q0 >= 128 ? q0 - 128 : 0) >> 7) : 0, tp1 = (q0 + 256) >> 7;
    const int srow = tid >> 3, sch = tid & 7;
    const int vrow = lane, vch = wid;
    const int vpos = (vrow & ~12) | ((vrow & 4) << 1) | ((vrow & 8) >> 1);
    const unsigned koff = (unsigned)(srow * kp + 8 * sch) * 2u, voff = (unsigned)(vrow * vp + 8 * vch) * 2u, kroff = (unsigned)((tid >> 2) * krp + 8 * (tid & 3)) * 2u;
    const bool do_kr = (NDS == 6) && tid < 256;
    u32x4 kreg0, vreg0, krreg0 = (u32x4){0u, 0u, 0u, 0u}, kreg1, vreg1, krreg1 = (u32x4){0u, 0u, 0u, 0u};
#define AT_GLOAD(tp) do { const size_t ro_ = (size_t)(tp) * 128; \
        const char* kt_ = (const char*)(K + ro_ * kp); const char* vt2_ = (const char*)(V + ro_ * vp); \
        kreg0 = *(g_u32x4*)(kt_ + koff); kreg1 = *(g_u32x4*)(kt_ + (size_t)64 * kp * 2 + koff); vreg0 = *(g_u32x4*)(vt2_ + voff); vreg1 = *(g_u32x4*)(vt2_ + (size_t)64 * vp * 2 + voff); \
        if (do_kr) { const char* rt_ = (const char*)(KR + ro_ * krp); krreg0 = *(g_u32x4*)(rt_ + kroff); krreg1 = *(g_u32x4*)(rt_ + (size_t)64 * krp * 2 + kroff); } } while (0)
#define AT_LW1(boff, kreg, vreg, krreg) do { LAS unsigned char* kb_ = lds + (boff); LAS unsigned short* vt_ = (LAS unsigned short*)(kb_ + 64 * KSTR * 2); \
        *(LAS u32x4*)(kb_ + (srow * KSTR + 8 * sch) * 2) = kreg; \
        if (do_kr) *(LAS u32x4*)(kb_ + ((tid >> 2) * KSTR + 64 + 8 * (tid & 3)) * 2) = krreg; \
        vt_[(8 * vch + 0) * VSTR + vpos] = (unsigned short)(vreg.x & 0xffffu); vt_[(8 * vch + 1) * VSTR + vpos] = (unsigned short)(vreg.x >> 16); \
        vt_[(8 * vch + 2) * VSTR + vpos] = (unsigned short)(vreg.y & 0xffffu); vt_[(8 * vch + 3) * VSTR + vpos] = (unsigned short)(vreg.y >> 16); \
        vt_[(8 * vch + 4) * VSTR + vpos] = (unsigned short)(vreg.z & 0xffffu); vt_[(8 * vch + 5) * VSTR + vpos] = (unsigned short)(vreg.z >> 16); \
        vt_[(8 * vch + 6) * VSTR + vpos] = (unsigned short)(vreg.w & 0xffffu); vt_[(8 * vch + 7) * VSTR + vpos] = (unsigned short)(vreg.w >> 16); } while (0)
#define AT_LWRITE(buf) do { AT_LW1((buf) * ABUF2, kreg0, vreg0, krreg0); AT_LW1((buf) * ABUF2 + ABUF, kreg1, vreg1, krreg1); } while (0)
    f32x16 o0, o1;
#pragma unroll
    for (int r = 0; r < 16; ++r) { o0[r] = 0.f; o1[r] = 0.f; }
    float m_run = (MODE == 1) ? m_init : 0.f, l_run = l_init;
    bool first = (MODE == 0);
    f32x16 negm;
#pragma unroll
    for (int r = 0; r < 16; ++r) negm[r] = -m_run;
    AT_GLOAD(tp0); AT_LWRITE(0);
    __syncthreads();
    int buf = 0;
    for (int tp = tp0; tp < tp1; ++tp) {
        if (tp + 1 < tp1) AT_GLOAD(tp + 1);
#pragma unroll
        for (int h = 0; h < 2; ++h) {
        const int kv0 = (2 * tp + h) * 64;
        bool active, needmask;
        if (MODE == 0) { active = kv0 <= qw0 + 31; needmask = kv0 + 63 > qw0; }
        else { active = (kv0 <= qw0 + 31) && (kv0 + 63 >= qw0 - 127); needmask = !((kv0 + 63 <= qw0) && (kv0 >= qw0 + 31 - 127)); }
        if (active) {
            const LAS unsigned char* kb = lds + buf * ABUF2 + h * ABUF + (r32 * KSTR + 8 * hi) * 2;
            const LAS unsigned char* vb = lds + buf * ABUF2 + h * ABUF + 64 * KSTR * 2 + (r32 * VSTR + 8 * hi) * 2;
            f32x16 p0, p1;
            { bf16x8 ka_[NDS], kc_[NDS];
#pragma unroll
              for (int d0 = 0; d0 < NDS; ++d0) { ka_[d0] = *(const LAS bf16x8*)(kb + d0 * 32); kc_[d0] = *(const LAS bf16x8*)(kb + 32 * KSTR * 2 + d0 * 32); }
              __builtin_amdgcn_sched_barrier(0);
#pragma unroll
              for (int d0 = 0; d0 < NDS; ++d0) {
                if (d0 == 0) { p0 = __builtin_amdgcn_mfma_f32_32x32x16_bf16(ka_[0], qr[0], negm, 0, 0, 0); p1 = __builtin_amdgcn_mfma_f32_32x32x16_bf16(kc_[0], qr[0], negm, 0, 0, 0); }
                else { p0 = __builtin_amdgcn_mfma_f32_32x32x16_bf16(ka_[d0], qr[d0], p0, 0, 0, 0); p1 = __builtin_amdgcn_mfma_f32_32x32x16_bf16(kc_[d0], qr[d0], p1, 0, 0, 0); }
              } }
            bf16x8 vf_[8];
#pragma unroll
            for (int c = 0; c < 4; ++c) { vf_[2 * c] = *(const LAS bf16x8*)(vb + c * 32); vf_[2 * c + 1] = *(const LAS bf16x8*)(vb + 32 * VSTR * 2 + c * 32); }
            __builtin_amdgcn_sched_barrier(0);
            asm volatile("s_nop 15\n\ts_nop 7" : "+v"(p0), "+v"(p1));
            if (needmask) {
                const int qa = qw0 + r32;
#pragma unroll
                for (int r = 0; r < 16; ++r) {
                    const int kv = kv0 + crow(r, hi);
                    bool k0 = kv > qa, k1 = kv + 32 > qa;
                    if (MODE == 1) { k0 = k0 || (kv + 128 <= qa); k1 = k1 || (kv + 32 + 128 <= qa); }
                    if (k0) p0[r] = -1e30f;
                    if (k1) p1[r] = -1e30f;
                }
            }
            float mxa = max3f(p0[0], p0[1], p1[0]), mxb = max3f(p0[2], p0[3], p1[1]); mxa = max3f(mxa, p1[2], p1[3]);
#pragma unroll
            for (int r = 4; r < 16; r += 4) { mxa = max3f(mxa, p0[r], p0[r + 1]); mxb = max3f(mxb, p0[r + 2], p0[r + 3]); mxa = max3f(mxa, p1[r], p1[r + 1]); mxb = max3f(mxb, p1[r + 2], p1[r + 3]); }
            float mx = max3f(mxa, mxb, mxb);
            mx = max3f(mx, shfl_x(mx, 32, lane), mx);
            if (first || __builtin_amdgcn_ballot_w64(mx > RESC_THR) != 0ull) {
                const float dl = first ? mx : fmaxf(mx, 0.f);
                const float f = first ? 1.0f : __builtin_amdgcn_exp2f(-dl);
                m_run += dl; l_run *= f;
#pragma unroll
                for (int r = 0; r < 16; ++r) { p0[r] -= dl; p1[r] -= dl; o0[r] *= f; o1[r] *= f; negm[r] = -m_run; }
                first = false;
            }
            float ls0 = 0.f, ls1 = 0.f;
#define AT_Q(P, B, c) do { \
            _Pragma("unroll") for (int r = 0; r < 8; ++r) P[(B) + r] = __builtin_amdgcn_exp2f(P[(B) + r]); \
            ls0 += (P[(B)] + P[(B) + 1]) + (P[(B) + 2] + P[(B) + 3]); ls1 += (P[(B) + 4] + P[(B) + 5]) + (P[(B) + 6] + P[(B) + 7]); \
            u32x4 w_; w_.x = cvtpk_s(P[(B)], P[(B) + 1]); w_.y = cvtpk_s(P[(B) + 2], P[(B) + 3]); w_.z = cvtpk_s(P[(B) + 4], P[(B) + 5]); w_.w = cvtpk_s(P[(B) + 6], P[(B) + 7]); \
            const bf16x8 pf_ = __builtin_bit_cast(bf16x8, w_); \
            o0 = __builtin_amdgcn_mfma_f32_32x32x16_bf16(vf_[2 * (c)], pf_, o0, 0, 0, 0); o1 = __builtin_amdgcn_mfma_f32_32x32x16_bf16(vf_[2 * (c) + 1], pf_, o1, 0, 0, 0); } while (0)
            AT_Q(p0, 0, 0); AT_Q(p0, 8, 1); AT_Q(p1, 0, 2); AT_Q(p1, 8, 3);
#undef AT_Q
            l_run += ls0 + ls1;
#pragma unroll
            for (int i_ = 0; i_ < 4; ++i_) { __builtin_amdgcn_sched_group_barrier(0x002, 20, 0); __builtin_amdgcn_sched_group_barrier(0x008, 2, 0); }
        }
        }
        if (tp + 1 < tp1) AT_LWRITE(buf ^ 1);
        __syncthreads();
        buf ^= 1;
    }
#undef AT_GLOAD
#undef AT_LW1
#undef AT_LWRITE
    const float lt = l_run + shfl_x(l_run, 32, lane);
    const float inv = 1.0f / lt;
    bf16_t* orow = O + (size_t)(qw0 + r32) * op + 4 * hi;
#pragma unroll
    for (int rg = 0; rg < 4; ++rg) {
        u32x2 a, b;
        a.x = cvtpk(o0[4 * rg] * inv, o0[4 * rg + 1] * inv); a.y = cvtpk(o0[4 * rg + 2] * inv, o0[4 * rg + 3] * inv);
        b.x = cvtpk(o1[4 * rg] * inv, o1[4 * rg + 1] * inv); b.y = cvtpk(o1[4 * rg + 2] * inv, o1[4 * rg + 3] * inv);
        *(u32x2*)(orow + 8 * rg) = a; *(u32x2*)(orow + 32 + 8 * rg) = b;
    }
    { float q = 0.f;
#pragma unroll
      for (int r = 0; r < 16; ++r) { const float a = o0[r] * inv, b = o1[r] * inv; q += a * a + b * b; }
      q += shfl_x(q, 32, lane);
      if (hi == 0) __hip_atomic_fetch_add(gss + qw0 + r32, (unsigned long long)(q * 16777216.0f), __ATOMIC_RELAXED, __HIP_MEMORY_SCOPE_AGENT); }
    __builtin_amdgcn_s_setprio(0);
}

constexpr int SWK = 72, SWT = 2 * 64 * SWK * 2;
__device__ __forceinline__ void swa_unit3(LAS unsigned char* lds, const bf16_t* pb  , bf16_t* Yb  , int q0, int kvh,
                                          const float* sinks  , unsigned long long* gss, const int wave_s) {
    const int tid = opaque_tid(wave_s), lane = tid & 63, wid = __builtin_amdgcn_readfirstlane(tid >> 6), r32 = lane & 31, hi = lane >> 5;
    const int qw0 = q0 + 32 * wid;
    const int kstart = q0 >= 128 ? q0 - 128 : 0, ntile = (q0 + 256 - kstart) >> 6;
    bf16x8 qr[3][4];
#pragma unroll
    for (int g = 0; g < 3; ++g) { const bf16_t* qrow = pb + (size_t)(qw0 + r32) * PJP + PC_AQ + 64 * (3 * kvh + g) + 8 * hi;
#pragma unroll
        for (int d0 = 0; d0 < 4; ++d0) qr[g][d0] = *(g_bf16x8*)(qrow + 16 * d0); }
    {
        const int srow = tid >> 3, sch = tid & 7, vrow = lane, vch = wid;
        const int vpos = (vrow & ~12) | ((vrow & 4) << 1) | ((vrow & 8) >> 1);
        const bf16_t* kg = pb + (size_t)(kstart + srow) * PJP + PC_AK + 64 * kvh + 8 * sch;
        const bf16_t* vg = pb + (size_t)(kstart + vrow) * PJP + PC_AV + 64 * kvh + 8 * vch;
        u32x4 kreg[6], vreg[6];
#pragma unroll
        for (int t = 0; t < 6; ++t) if (t < ntile) { kreg[t] = *(g_u32x4*)(kg + (size_t)t * 64 * PJP); vreg[t] = *(g_u32x4*)(vg + (size_t)t * 64 * PJP); }
#pragma unroll
        for (int t = 0; t < 6; ++t) if (t < ntile) {
            LAS unsigned char* kb_ = lds + t * SWT; LAS unsigned short* vt_ = (LAS unsigned short*)(kb_ + 64 * SWK * 2);
            *(LAS u32x4*)(kb_ + (srow * SWK + 8 * sch) * 2) = kreg[t];
            const u32x4 vr = vreg[t];
            vt_[(8 * vch + 0) * SWK + vpos] = (unsigned short)(vr.x & 0xffffu); vt_[(8 * vch + 1) * SWK + vpos] = (unsigned short)(vr.x >> 16);
            vt_[(8 * vch + 2) * SWK + vpos] = (unsigned short)(vr.y & 0xffffu); vt_[(8 * vch + 3) * SWK + vpos] = (unsigned short)(vr.y >> 16);
            vt_[(8 * vch + 4) * SWK + vpos] = (unsigned short)(vr.z & 0xffffu); vt_[(8 * vch + 5) * SWK + vpos] = (unsigned short)(vr.z >> 16);
            vt_[(8 * vch + 6) * SWK + vpos] = (unsigned short)(vr.w & 0xffffu); vt_[(8 * vch + 7) * SWK + vpos] = (unsigned short)(vr.w >> 16);
        }
    }
    __syncthreads();
#pragma unroll
    for (int g = 0; g < 3; ++g) {
        const int hq = 3 * kvh + g;
        float m_run = sinks[hq] * LOG2E, l_run = 0.5f;
        f32x16 o0, o1, negm;
#pragma unroll
        for (int r = 0; r < 16; ++r) { o0[r] = 0.f; o1[r] = 0.f; negm[r] = -m_run; }
#pragma unroll 1
        for (int t = 0; t < ntile; ++t) {
            const int kv0 = kstart + 64 * t;
            const bool active = (kv0 <= qw0 + 31) && (kv0 + 63 >= qw0 - 127);
            if (!active) continue;
            const bool needmask = !((kv0 + 63 <= qw0) && (kv0 >= qw0 + 31 - 127));
            const LAS unsigned char* kb = lds + t * SWT + (r32 * SWK + 8 * hi) * 2;
            const LAS unsigned char* vb = lds + t * SWT + 64 * SWK * 2 + (r32 * SWK + 8 * hi) * 2;
            f32x16 p0, p1;
            { bf16x8 ka_[4], kc_[4];
#pragma unroll
              for (int d0 = 0; d0 < 4; ++d0) { ka_[d0] = *(const LAS bf16x8*)(kb + d0 * 32); kc_[d0] = *(const LAS bf16x8*)(kb + 32 * SWK * 2 + d0 * 32); }
              __builtin_amdgcn_sched_barrier(0);
#pragma unroll
              for (int d0 = 0; d0 < 4; ++d0) {
                if (d0 == 0) { p0 = __builtin_amdgcn_mfma_f32_32x32x16_bf16(ka_[0], qr[g][0], negm, 0, 0, 0); p1 = __builtin_amdgcn_mfma_f32_32x32x16_bf16(kc_[0], qr[g][0], negm, 0, 0, 0); }
                else { p0 = __builtin_amdgcn_mfma_f32_32x32x16_bf16(ka_[d0], qr[g][d0], p0, 0, 0, 0); p1 = __builtin_amdgcn_mfma_f32_32x32x16_bf16(kc_[d0], qr[g][d0], p1, 0, 0, 0); }
              } }
            bf16x8 vf_[8];
#pragma unroll
            for (int c = 0; c < 4; ++c) { vf_[2 * c] = *(const LAS bf16x8*)(vb + c * 32); vf_[2 * c + 1] = *(const LAS bf16x8*)(vb + 32 * SWK * 2 + c * 32); }
            __builtin_amdgcn_sched_barrier(0);
            asm volatile("s_nop 15\n\ts_nop 7" : "+v"(p0), "+v"(p1));
            if (needmask) {
                const int qa = qw0 + r32;
#pragma unroll
                for (int r = 0; r < 16; ++r) {
                    const int kv = kv0 + crow(r, hi);
                    if ((unsigned)(qa - kv) >= 128u) p0[r] = -1e30f;
                    if ((unsigned)(qa - kv - 32) >= 128u) p1[r] = -1e30f;
                }
            }
            float mxa = max3f(p0[0], p0[1], p1[0]), mxb = max3f(p0[2], p0[3], p1[1]); mxa = max3f(mxa, p1[2], p1[3]);
#pragma unroll
            for (int r = 4; r < 16; r += 4) { mxa = max3f(mxa, p0[r], p0[r + 1]); mxb = max3f(mxb, p0[r + 2], p0[r + 3]); mxa = max3f(mxa, p1[r], p1[r + 1]); mxb = max3f(mxb, p1[r + 2], p1[r + 3]); }
            float mx = max3f(mxa, mxb, mxb);
            mx = max3f(mx, shfl_x(mx, 32, lane), mx);
            if (__builtin_amdgcn_ballot_w64(mx > RESC_THR) != 0ull) {
                const float dl = fmaxf(mx, 0.f), f = __builtin_amdgcn_exp2f(-dl);
                m_run += dl; l_run *= f;
#pragma unroll
                for (int r = 0; r < 16; ++r) { p0[r] -= dl; p1[r] -= dl; o0[r] *= f; o1[r] *= f; negm[r] = -m_run; }
            }
            float ls0 = 0.f, ls1 = 0.f;
#define SW_Q(P, B, c) do { \
            _Pragma("unroll") for (int r = 0; r < 8; ++r) P[(B) + r] = __builtin_amdgcn_exp2f(P[(B) + r]); \
            ls0 += (P[(B)] + P[(B) + 1]) + (P[(B) + 2] + P[(B) + 3]); ls1 += (P[(B) + 4] + P[(B) + 5]) + (P[(B) + 6] + P[(B) + 7]); \
            u32x4 w_; w_.x = cvtpk_s(P[(B)], P[(B) + 1]); w_.y = cvtpk_s(P[(B) + 2], P[(B) + 3]); w_.z = cvtpk_s(P[(B) + 4], P[(B) + 5]); w_.w = cvtpk_s(P[(B) + 6], P[(B) + 7]); \
            const bf16x8 pf_ = __builtin_bit_cast(bf16x8, w_); \
            o0 = __builtin_amdgcn_mfma_f32_32x32x16_bf16(vf_[2 * (c)], pf_, o0, 0, 0, 0); o1 = __builtin_amdgcn_mfma_f32_32x32x16_bf16(vf_[2 * (c) + 1], pf_, o1, 0, 0, 0); } while (0)
            SW_Q(p0, 0, 0); SW_Q(p0, 8, 1); SW_Q(p1, 0, 2); SW_Q(p1, 8, 3);
#undef SW_Q
            l_run += ls0 + ls1;
        }
        const float lt = l_run + shfl_x(l_run, 32, lane);
        const float inv = 1.0f / lt;
        bf16_t* orow = Yb + (size_t)(qw0 + r32) * DM + 64 * hq + 4 * hi;
#pragma unroll
        for (int rg = 0; rg < 4; ++rg) {
            u32x2 a, b;
            a.x = cvtpk(o0[4 * rg] * inv, o0[4 * rg + 1] * inv); a.y = cvtpk(o0[4 * rg + 2] * inv, o0[4 * rg + 3] * inv);
            b.x = cvtpk(o1[4 * rg] * inv, o1[4 * rg + 1] * inv); b.y = cvtpk(o1[4 * rg + 2] * inv, o1[4 * rg + 3] * inv);
            *(u32x2*)(orow + 8 * rg) = a; *(u32x2*)(orow + 32 + 8 * rg) = b;
        }
        { float q = 0.f;
#pragma unroll
          for (int r = 0; r < 16; ++r) { const float a = o0[r] * inv, b = o1[r] * inv; q += a * a + b * b; }
          q += shfl_x(q, 32, lane);
          if (hi == 0) __hip_atomic_fetch_add(gss + qw0 + r32, (unsigned long long)(q * 16777216.0f), __ATOMIC_RELAXED, __HIP_MEMORY_SCOPE_AGENT); }
    }
    __syncthreads();
}

constexpr int SSTR = 136;
__device__ __forceinline__ void sgu_unit(LAS unsigned char* lds, const bf16_t* proj, bf16_t* Y, const bf16_t* wsb  , const float* lnw, const float* lnb, const float* bs  , int row0, unsigned long long* gss, const int wave_s) {
    const int tid = opaque_tid(wave_s), lane = tid & 63, wid = __builtin_amdgcn_readfirstlane(tid >> 6), r32 = lane & 31, hi = lane >> 5;
    LAS unsigned short* vt = (LAS unsigned short*)lds;
    {
        const int s = tid >> 2, q = tid & 3;
        const u32x4* src = (const u32x4*)(proj + (size_t)(row0 + s) * PJP + PC_CV + 64 * q);
        float v[64]; float sum = 0.f;
#pragma unroll
        for (int i = 0; i < 8; ++i) { const u32x4 w = src[i];
            v[8 * i + 0] = bflo(w.x); v[8 * i + 1] = bfhi(w.x); v[8 * i + 2] = bflo(w.y); v[8 * i + 3] = bfhi(w.y);
            v[8 * i + 4] = bflo(w.z); v[8 * i + 5] = bfhi(w.z); v[8 * i + 6] = bflo(w.w); v[8 * i + 7] = bfhi(w.w); }
#pragma unroll
        for (int i = 0; i < 64; ++i) sum += v[i];
        sum += shfl_x(sum, 1, lane); sum += shfl_x(sum, 2, lane);
        const float mu = sum * (1.0f / 256.0f); float sq = 0.f;
#pragma unroll
        for (int i = 0; i < 64; ++i) { v[i] -= mu; sq += v[i] * v[i]; }
        sq += shfl_x(sq, 1, lane); sq += shfl_x(sq, 2, lane);
        const float rstd = 1.0f / sqrtf(sq * (1.0f / 256.0f) + EPS);
#pragma unroll
        for (int i = 0; i < 64; i += 2) {
            const int c = 64 * q + i;
            const float a = v[i] * rstd * lnw[c] + lnb[c], b = v[i + 1] * rstd * lnw[c + 1] + lnb[c + 1];
            const unsigned w = cvtpk(a, b);
            vt[c * SSTR + s] = (unsigned short)(w & 0xffffu); vt[(c + 1) * SSTR + s] = (unsigned short)(w >> 16);
        }
    }
    __syncthreads();
    const int g = wid >> 1, dh = wid & 1;
    const LAS unsigned char* ab = lds + ((64 * g + 32 * dh + r32) * SSTR + 8 * hi) * 2;
    const bf16_t* wg = wsb + (size_t)g * 128 * 128;
#pragma unroll 1
    for (int tt = 0; tt < 4; ++tt) {
        f32x16 acc;
#pragma unroll
        for (int r = 0; r < 16; ++r) acc[r] = 0.f;
        const bf16_t* wrow = wg + (size_t)(32 * tt + r32) * 128 + 8 * hi;
        const int nk = 2 * (tt + 1);
        bf16x8 wf[8];
#pragma unroll
        for (int k = 0; k < 8; ++k) if (k < nk) wf[k] = *(g_bf16x8*)(wrow + 16 * k);
#pragma unroll
        for (int k = 0; k < 8; ++k) if (k < nk) {
            const bf16x8 a = *(const LAS bf16x8*)(ab + k * 32);
            acc = __builtin_amdgcn_mfma_f32_32x32x16_bf16(a, wf[k], acc, 0, 0, 0);
        }
        const int t = 32 * tt + r32; const size_t row = (size_t)row0 + t;
        const float bias = bs[g * 128 + t];
        const int cb = 64 * g + 32 * dh + 4 * hi; float qs = 0.f;
        u32x2 uwv[4];
#pragma unroll
        for (int rg = 0; rg < 4; ++rg) uwv[rg] = *(const u32x2*)(proj + row * PJP + PC_CU + cb + 8 * rg);
#pragma unroll
        for (int rg = 0; rg < 4; ++rg) {
            const u32x2 uw = uwv[rg];
            const float y0 = bflo(uw.x) * (acc[4 * rg] + bias), y1 = bfhi(uw.x) * (acc[4 * rg + 1] + bias), y2 = bflo(uw.y) * (acc[4 * rg + 2] + bias), y3 = bfhi(uw.y) * (acc[4 * rg + 3] + bias);
            u32x2 o; o.x = cvtpk(y0, y1); o.y = cvtpk(y2, y3);
            *(u32x2*)(Y + row * DM + 768 + cb + 8 * rg) = o;
            qs += (y0 * y0 + y1 * y1) + (y2 * y2 + y3 * y3);
        }
        qs += shfl_x(qs, 32, lane);
        if (hi == 0) __hip_atomic_fetch_add(gss + row, (unsigned long long)(qs * 16777216.0f), __ATOMIC_RELAXED, __HIP_MEMORY_SCOPE_AGENT);
    }
    __syncthreads();
}

__device__ __forceinline__ void norm_mod_pass(const float* x, const float* nw, const float* sh, const float* sc, bf16_t* H, int vcu, int ngw, const int wave_s) {
    const int tid_ = opaque_tid(wave_s), lane = tid_ & 63, gw = vcu * NWAVES + (tid_ >> 6);
    f32x4 wv[4];
#pragma unroll
    for (int j = 0; j < 4; ++j) wv[j] = *(const f32x4*)(nw + 4 * lane + 256 * j);
    for (int m_ = gw; m_ < REP_PASS * MTOK; m_ += ngw) {
        const int m = m_ % MTOK; const int b = m >> 12;
        const f32x4* xr = (const f32x4*)(x + (size_t)m * DM) + lane;
        f32x4 v[4]; float s = 0.f;
#pragma unroll
        for (int j = 0; j < 4; ++j) { v[j] = xr[64 * j]; s += (v[j].x * v[j].x + v[j].y * v[j].y) + (v[j].z * v[j].z + v[j].w * v[j].w); }
        const float rstd = 1.0f / sqrtf(wave_sum(s, lane) * (1.0f / DM) + EPS);
        unsigned long long* o8 = (unsigned long long*)(H + (size_t)m * DM) + lane;
#pragma unroll
        for (int j = 0; j < 4; ++j) {
            const f32x4 scv = *(const f32x4*)(sc + (size_t)b * NMOD + 4 * lane + 256 * j), shv = *(const f32x4*)(sh + (size_t)b * NMOD + 4 * lane + 256 * j);
            const f32x4 h = v[j] * rstd * wv[j] * (scv + 1.0f) + shv;
            o8[64 * j] = (unsigned long long)cvtpk(h.x, h.y) | ((unsigned long long)cvtpk(h.z, h.w) << 32);
        }
    }
}
__device__ __forceinline__ void group_norm_pass(const bf16_t* Y, const float* gwt, bf16_t* H, int vcu, int ngw, const int wave_s) {
    const int tid_ = opaque_tid(wave_s), lane = tid_ & 63, gw = vcu * NWAVES + (tid_ >> 6);
    const int seg = lane < 24 ? 0 : (lane < 48 ? 1 : 2);
    float g[16];
#pragma unroll
    for (int i = 0; i < 16; ++i) g[i] = gwt[16 * lane + i];
    for (int m_ = gw; m_ < REP_PASS * MTOK; m_ += ngw) {
        const int m = m_ % MTOK; const u32x4* yr = (const u32x4*)(Y + (size_t)m * DM + 16 * lane);
        const u32x4 a = yr[0], b = yr[1];
        float v[16];
        v[0] = bflo(a.x); v[1] = bfhi(a.x); v[2] = bflo(a.y); v[3] = bfhi(a.y); v[4] = bflo(a.z); v[5] = bfhi(a.z); v[6] = bflo(a.w); v[7] = bfhi(a.w);
        v[8] = bflo(b.x); v[9] = bfhi(b.x); v[10] = bflo(b.y); v[11] = bfhi(b.y); v[12] = bflo(b.z); v[13] = bfhi(b.z); v[14] = bflo(b.w); v[15] = bfhi(b.w);
        float s = 0.f;
#pragma unroll
        for (int i = 0; i < 16; ++i) s += v[i] * v[i];
        const float s0 = wave_sum(seg == 0 ? s : 0.f, lane), s1 = wave_sum(seg == 1 ? s : 0.f, lane), s2 = wave_sum(seg == 2 ? s : 0.f, lane);
        const float rstd = seg == 0 ? 1.0f / sqrtf(s0 * (1.0f / 384.0f) + EPS) : (seg == 1 ? 1.0f / sqrtf(s1 * (1.0f / 384.0f) + EPS) : 1.0f / sqrtf(s2 * (1.0f / 256.0f) + EPS));
        u32x4 oa, ob;
        oa.x = cvtpk(v[0] * rstd * g[0], v[1] * rstd * g[1]); oa.y = cvtpk(v[2] * rstd * g[2], v[3] * rstd * g[3]);
        oa.z = cvtpk(v[4] * rstd * g[4], v[5] * rstd * g[5]); oa.w = cvtpk(v[6] * rstd * g[6], v[7] * rstd * g[7]);
        ob.x = cvtpk(v[8] * rstd * g[8], v[9] * rstd * g[9]); ob.y = cvtpk(v[10] * rstd * g[10], v[11] * rstd * g[11]);
        ob.z = cvtpk(v[12] * rstd * g[12], v[13] * rstd * g[13]); ob.w = cvtpk(v[14] * rstd * g[14], v[15] * rstd * g[15]);
        u32x4* orow = (u32x4*)(H + (size_t)m * DM + 16 * lane);
        orow[0] = oa; orow[1] = ob;
    }
}
__device__ __forceinline__ void final_norm_pass(const bf16_t* x16, float* out, const float* nw, int vcu, int ngw, const int wave_s) {
    const int tid_ = opaque_tid(wave_s), lane = tid_ & 63, gw = vcu * NWAVES + (tid_ >> 6);
    f32x4 wv[4];
#pragma unroll
    for (int j = 0; j < 4; ++j) wv[j] = *(const f32x4*)(nw + 16 * lane + 4 * j);
    for (int m0 = 4 * gw; m0 < MTOK; m0 += 4 * ngw) {
        u32x4 a[4], b[4];
#pragma unroll
        for (int i = 0; i < 4; ++i) { const u32x4* xr = (const u32x4*)(x16 + (size_t)(m0 + i) * DM + 16 * lane); a[i] = xr[0]; b[i] = xr[1]; }
#pragma unroll
        for (int i = 0; i < 4; ++i) {
            f32x4 v[4];
            v[0] = (f32x4){bflo(a[i].x), bfhi(a[i].x), bflo(a[i].y), bfhi(a[i].y)}; v[1] = (f32x4){bflo(a[i].z), bfhi(a[i].z), bflo(a[i].w), bfhi(a[i].w)};
            v[2] = (f32x4){bflo(b[i].x), bfhi(b[i].x), bflo(b[i].y), bfhi(b[i].y)}; v[3] = (f32x4){bflo(b[i].z), bfhi(b[i].z), bflo(b[i].w), bfhi(b[i].w)};
            float s = 0.f;
#pragma unroll
            for (int j = 0; j < 4; ++j) s += (v[j].x * v[j].x + v[j].y * v[j].y) + (v[j].z * v[j].z + v[j].w * v[j].w);
            const float rstd = 1.0f / sqrtf(wave_sum(s, lane) * (1.0f / DM) + EPS);
            f32x4* orow = (f32x4*)(out + (size_t)(m0 + i) * DM + 16 * lane);
#pragma unroll
            for (int j = 0; j < 4; ++j) orow[j] = v[j] * rstd * wv[j];
        }
    }
}
__device__ __forceinline__ void xg_pass(const float* x, const float* nw, const float* sc, bf16_t* XGp, bf16_t* X16p, unsigned long long* ssq, int vcu, int ngw, const int wave_s) {
    const int tid_ = opaque_tid(wave_s), lane = tid_ & 63, gw = vcu * NWAVES + (tid_ >> 6);
    f32x4 wv[4];
#pragma unroll
    for (int j = 0; j < 4; ++j) wv[j] = *(const f32x4*)(nw + 4 * lane + 256 * j);
    for (int m0 = 2 * gw; m0 < MTOK; m0 += 2 * ngw) {
        const int b = m0 >> 12;
        f32x4 v[2][4], scv[4];
#pragma unroll
        for (int i = 0; i < 2; ++i)
#pragma unroll
            for (int j = 0; j < 4; ++j) v[i][j] = ((const f32x4*)(x + (size_t)(m0 + i) * DM) + lane)[64 * j];
#pragma unroll
        for (int j = 0; j < 4; ++j) scv[j] = *(const f32x4*)(sc + (size_t)b * NMOD + 4 * lane + 256 * j);
#pragma unroll
        for (int i = 0; i < 2; ++i) {
            const int m = m0 + i; float s = 0.f;
#pragma unroll
            for (int j = 0; j < 4; ++j) s += (v[i][j].x * v[i][j].x + v[i][j].y * v[i][j].y) + (v[i][j].z * v[i][j].z + v[i][j].w * v[i][j].w);
            s = wave_sum(s, lane);
            if (lane == 0) ssq[m] = (unsigned long long)(s * 16777216.0f);
            unsigned long long* o8 = (unsigned long long*)(XGp + (size_t)m * DM) + lane;
            unsigned long long* x8 = (unsigned long long*)(X16p + (size_t)m * DM) + lane;
#pragma unroll
            for (int j = 0; j < 4; ++j) {
                const f32x4 h = v[i][j] * wv[j] * (scv[j] + 1.0f);
                o8[64 * j] = (unsigned long long)cvtpk(h.x, h.y) | ((unsigned long long)cvtpk(h.z, h.w) << 32);
                x8[64 * j] = (unsigned long long)cvtpk(v[i][j].x, v[i][j].y) | ((unsigned long long)cvtpk(v[i][j].z, v[i][j].w) << 32);
            }
        }
    }
}
__device__ __forceinline__ void shw_tasks(const float* modp, const bf16_t* win, const bf16_t* wgu, float* shw, int vcu, int ngw, const int wave_s) {
    const int tid_ = opaque_tid(wave_s), lane = tid_ & 63, gw = vcu * NWAVES + (tid_ >> 6), r32 = lane & 31, hi = lane >> 5;
    for (int task = gw; task < DEPTH * 240; task += ngw) {
        const int l = task / 240, n0 = 32 * (task % 240);
        const bf16_t* wrow = (n0 < PJ) ? (win + l * WIN_L + (size_t)(n0 + r32) * DM) : (wgu + l * WGU_L + (size_t)(n0 - PJ + r32) * DM);
        const float* shp = modp + ((size_t)l * 16 + (r32 & 15)) * NMOD + (n0 < PJ ? 0 : 3 * DM) + 8 * hi;
        f32x16 acc;
#pragma unroll
        for (int r = 0; r < 16; ++r) acc[r] = 0.f;
#pragma unroll 16
        for (int k = 0; k < 64; ++k) {
            const f32x4 a0 = *(const f32x4*)(shp + 16 * k), a1 = *(const f32x4*)(shp + 16 * k + 4);
            u32x4 aw; aw.x = cvtpk(a0.x, a0.y); aw.y = cvtpk(a0.z, a0.w); aw.z = cvtpk(a1.x, a1.y); aw.w = cvtpk(a1.z, a1.w);
            const bf16x8 bfr = *(const bf16x8*)(wrow + 16 * k + 8 * hi);
            acc = __builtin_amdgcn_mfma_f32_32x32x16_bf16(__builtin_bit_cast(bf16x8, aw), bfr, acc, 0, 0, 0);
        }
#pragma unroll
        for (int r = 0; r < 8; ++r) shw[((size_t)l * 16 + crow(r, hi)) * 7680 + n0 + r32] = acc[r];
    }
}

__device__ __forceinline__ int map_col(int mat, int n) {
    if (mat == 0) {
        if (n < 512) { const int hh = n >> 6, i = n & 63; return hh * 64 + (i >> 1) + 32 * (i & 1); }
        if (n < 640) return n;
        if (n < 672) { const int i = n - 640; return 1280 + (i >> 1) + 16 * (i & 1); }
        if (n < 768) return -1;
        if (n < 1152) return 640 + (n - 768);
        if (n < 1408) return 1024 + (n - 1152);
        if (n < 1536) return -1;
        if (n < 1792) return 1312 + (n - 1536);
        return 1568 + (n - 1792);
    } else if (mat == 1) {
        if (n >= 576) return -1;
        const int h = n / 96, i = n - 96 * h;
        if (i < 64) return 96 * h + i;
        const int ii = i - 64; return 96 * h + 64 + (ii >> 1) + 16 * (ii & 1);
    } else if (mat == 4) {
        const int pn = n >> 8, bj = (n >> 7) & 1, i = n & 127; return (bj ? FFN : 0) + 128 * pn + i;
    }
    return n;
}
__device__ __forceinline__ void transpose_item(const float* W, int K, int Nsrc, bf16_t* WT, int kb, int nb, int mat, const float* kscale, LAS float* scr, int lane) {
    const int k0 = 64 * kb, n0 = 32 * nb;
    const int scol = map_col(mat, n0 + (lane & 31));
    float tv[32];
#pragma unroll
    for (int i = 0; i < 32; ++i) { const int kk = 2 * i + (lane >> 5); tv[i] = scol >= 0 ? W[(size_t)(k0 + kk) * Nsrc + scol] : 0.f; }
#pragma unroll
    for (int i = 0; i < 32; ++i) { const int kk = 2 * i + (lane >> 5); float v = tv[i]; if (kscale) v *= kscale[k0 + kk]; scr[kk * 33 + (lane & 31)] = v; }
    asm volatile("s_waitcnt lgkmcnt(0)" ::: "memory");
    const int c = lane & 7;
#pragma unroll
    for (int j = 0; j < 4; ++j) { const int n = (lane >> 3) + 8 * j; const LAS float* s = scr + (8 * c) * 33 + n;
        u32x4 o; o.x = cvtpk(s[0 * 33], s[1 * 33]); o.y = cvtpk(s[2 * 33], s[3 * 33]); o.z = cvtpk(s[4 * 33], s[5 * 33]); o.w = cvtpk(s[6 * 33], s[7 * 33]);
        *(u32x4*)(WT + (size_t)(n0 + n) * K + k0 + 8 * c) = o; }
    asm volatile("s_waitcnt lgkmcnt(0)" ::: "memory");
}
__device__ __forceinline__ void sincos_rev(float angf, float& c, float& s) {
    double rev = (double)angf * 0.15915494309189535; rev -= floor(rev);
    const double q4 = rev * 4.0; const double qn = rint(q4); const float r = (float)((q4 - qn) * 1.5707963267948966);
    const int q = ((int)qn) & 3; const float r2 = r * r;
    const float sn = r * (1.0f + r2 * (-1.0f / 6.0f + r2 * (1.0f / 120.0f + r2 * (-1.0f / 5040.0f + r2 * (1.0f / 362880.0f)))));
    const float cs = 1.0f + r2 * (-0.5f + r2 * (1.0f / 24.0f + r2 * (-1.0f / 720.0f + r2 * (1.0f / 40320.0f))));
    c = (q == 0) ? cs : (q == 1) ? -sn : (q == 2) ? -cs : sn;
    s = (q == 0) ? sn : (q == 1) ? cs : (q == 2) ? -sn : -cs;
}

__device__ __forceinline__ void prologue(const Args& A, LAS unsigned char* lds, int vcu, int G, const int wave_s) {
    const int tid = opaque_tid(wave_s), lane = tid & 63, wid = __builtin_amdgcn_readfirstlane(tid >> 6);
    unsigned char* ws = A.ws;
    {
        LAS float* cact = (LAS float*)lds;
        LAS float* red = (LAS float*)(lds + 65536);
        const float* c = A.in[1];
        for (int idx = tid; idx < NBATCH * DM; idx += NTHR) { const int b = idx >> 10, k = idx & 1023; cact[k * 16 + b] = silu_f(c[idx]); }
        __syncthreads();
        float* mod = (float*)(ws + WS_MOD);
        for (int tsk = vcu; tsk < DEPTH * 96; tsk += G) {
            const int l = tsk / 96, cgp = tsk % 96, n = 64 * cgp + lane;
            const float* wp = A.in[3] + ((size_t)l * DM + (size_t)wid * 128) * NMOD + n;
            float acc[16];
#pragma unroll
            for (int b = 0; b < 16; ++b) acc[b] = 0.f;
#pragma unroll 16
            for (int kk = 0; kk < 128; ++kk) {
                const float w = wp[(size_t)kk * NMOD];
                const LAS f32x4* cp = (const LAS f32x4*)(cact + (wid * 128 + kk) * 16);
                const f32x4 c0 = cp[0], c1 = cp[1], c2 = cp[2], c3 = cp[3];
                acc[0] += c0.x * w; acc[1] += c0.y * w; acc[2] += c0.z * w; acc[3] += c0.w * w;
                acc[4] += c1.x * w; acc[5] += c1.y * w; acc[6] += c1.z * w; acc[7] += c1.w * w;
                acc[8] += c2.x * w; acc[9] += c2.y * w; acc[10] += c2.z * w; acc[11] += c2.w * w;
                acc[12] += c3.x * w; acc[13] += c3.y * w; acc[14] += c3.z * w; acc[15] += c3.w * w;
            }
#pragma unroll
            for (int b = 0; b < 16; ++b) red[(wid * 16 + b) * 64 + lane] = acc[b];
            __syncthreads();
            for (int o = tid; o < 1024; o += NTHR) { const int b = o >> 6, nn = o & 63; float s = A.in[4][(size_t)l * NMOD + 64 * cgp + nn];
#pragma unroll
                for (int k8 = 0; k8 < 8; ++k8) s += red[(k8 * 16 + b) * 64 + nn];
                mod[((size_t)l * 16 + b) * NMOD + 64 * cgp + nn] = s; }
            __syncthreads();
        }
        __syncthreads();
    }
    {
        LAS float* scr = (LAS float*)(lds + wid * 16384);
        const int gw = vcu * NWAVES + wid, ngw = G * NWAVES;
        constexpr int I_IN = 16 * 64, I_UQ = 6 * 24, I_UKV = 4 * 24, I_OUT = 16 * 32, I_GU = 16 * 176, I_DN = 44 * 32, I_L = I_IN + I_UQ + I_UKV + I_OUT + I_GU + I_DN;
        for (int it = gw; it < DEPTH * I_L; it += ngw) {
            const int l = it / I_L; int r = it - l * I_L;
            if (r < I_IN) { transpose_item(A.in[6] + (size_t)l * DM * INC, DM, INC, (bf16_t*)(ws + WS_WIN) + l * WIN_L, r / 64, r % 64, 0, nullptr, scr, lane); continue; } r -= I_IN;
            if (r < I_UQ) { transpose_item(A.in[9] + (size_t)l * 384 * 576, 384, 576, (bf16_t*)(ws + WS_WUQ) + l * WUQ_L, r / 24, r % 24, 1, A.in[8] + l * 384, scr, lane); continue; } r -= I_UQ;
            if (r < I_UKV) { transpose_item(A.in[11] + (size_t)l * 256 * 768, 256, 768, (bf16_t*)(ws + WS_WUKV) + l * WUKV_L, r / 24, r % 24, 2, A.in[10] + l * 256, scr, lane); continue; } r -= I_UKV;
            if (r < I_OUT) { transpose_item(A.in[17] + (size_t)l * DM * DM, DM, DM, (bf16_t*)(ws + WS_WOUT) + l * WOUT_L, r / 32, r % 32, 3, A.in[16] + l * DM, scr, lane); continue; } r -= I_OUT;
            if (r < I_GU) { transpose_item(A.in[19] + (size_t)l * DM * 2 * FFN, DM, 2 * FFN, (bf16_t*)(ws + WS_WGU) + l * WGU_L, r / 176, r % 176, 4, nullptr, scr, lane); continue; } r -= I_GU;
            transpose_item(A.in[20] + (size_t)l * FFN * DM, FFN, DM, (bf16_t*)(ws + WS_WDN) + l * WDN_L, r / 32, r % 32, 5, nullptr, scr, lane);
        }
    }
    {
        const int gt = vcu * NTHR + tid, ngt = G * NTHR;
        bf16_t* wsb = (bf16_t*)(ws + WS_WS);
        for (int i = gt; i < DEPTH * 4 * 128 * 128 / 2; i += ngt) { const int e = 2 * i, s = e & 127, t = (e >> 7) & 127; const float a = s <= t ? A.in[14][e] : 0.f, b = (s + 1) <= t ? A.in[14][e + 1] : 0.f;
            ((unsigned*)wsb)[i] = cvtpk(a, b); }
        unsigned long long* ssqz = (unsigned long long*)(ws + WS_SSQ);
        for (int i = gt; i < DEPTH * 8 * MTOK; i += ngt) ssqz[i] = 0ull;
        f32x2* ra = (f32x2*)(ws + WS_ROPA); f32x2* rb = (f32x2*)(ws + WS_ROPB);
        const int* pos = (const int*)A.in[2];
        for (int i0 = gt; i0 < MTOK * 48; i0 += 4 * ngt) {
            int pv[4];
#pragma unroll
            for (int j = 0; j < 4; ++j) { const int i = i0 + j * ngt; pv[j] = (i < MTOK * 48) ? pos[i / 48] : 0; }
#pragma unroll
            for (int j = 0; j < 4; ++j) { const int i = i0 + j * ngt; if (i < MTOK * 48) { const int tok = i / 48, e = i - tok * 48; const float angf = (float)pv[j] * A.inv[e]; float c, s; sincos_rev(angf, c, s);
                if (e < 32) ra[(size_t)tok * 32 + e] = (f32x2){c, s}; else rb[(size_t)tok * 16 + (e - 32)] = (f32x2){c, s}; } }
        }
    }
}

#define RLX_AGENT __ATOMIC_RELAXED, __HIP_MEMORY_SCOPE_AGENT
#define XB_TMO      128
#define XB_XCNT(j)  (256  + 64 * (j))
#define XB_XSUB(j)  (1280 + 64 * (j))
#define XB_XGEN(j)  (2304 + 64 * (j))
#define XB_TOP      3328
#define XB_TOPGEN   3392
#define XCD_BAR_WORDS 3456
#define XB_SPIN_CAP (1u << 18)

__device__ __forceinline__ unsigned xb_ld(unsigned* p)              { return __hip_atomic_load(p, __ATOMIC_RELAXED, __HIP_MEMORY_SCOPE_AGENT); }
__device__ __forceinline__ unsigned xb_add(unsigned* p, unsigned v) { return __hip_atomic_fetch_add(p, v, __ATOMIC_RELAXED, __HIP_MEMORY_SCOPE_AGENT); }
__device__ __forceinline__ unsigned xb_xcc_id() { return (unsigned)__builtin_amdgcn_s_getreg((3 << 11) | 20) & 0xFu; }
#define XB_SPIN(cond, bar) do { unsigned _sp = 0; while (cond) { __builtin_amdgcn_s_sleep(1); \
    if ((++_sp & 255u) == 0u) { if (xb_ld(&(bar)[XB_TMO])) break; if (_sp > XB_SPIN_CAP) { atomicAdd(&(bar)[XB_TMO], 1u); break; } } } } while (0)

struct XcdBarrier {
    unsigned* bar; unsigned x;
    volatile LAS unsigned* st;
};

__device__ __forceinline__ XcdBarrier xcd_barrier_post(unsigned* bar, volatile LAS unsigned* st) {
    XcdBarrier b; b.bar = bar; b.x = xb_xcc_id(); b.st = st;
    if (threadIdx.x == 0) (void)xb_add(&bar[XB_XCNT(b.x)], 1u);
    return b;
}
__device__ __forceinline__ void xcd_barrier_complete(unsigned* bar, unsigned x, unsigned& nloc, unsigned& nx) {
    const unsigned G = gridDim.x * gridDim.y * gridDim.z;
    unsigned sum, cnt, mine, sp = 0u;
    for (;;) {
        sum = 0u; cnt = 0u; mine = 0u;
#pragma unroll
        for (unsigned j = 0; j < 16; ++j) { const unsigned c = xb_ld(&bar[XB_XCNT(j)]); sum += c; cnt += (c > 0u) ? 1u : 0u; mine = (j == x) ? c : mine; }
        if (sum == G) break;
        __builtin_amdgcn_s_sleep(1);
        if ((++sp & 255u) == 0u) { if (xb_ld(&bar[XB_TMO])) break; if (sp > XB_SPIN_CAP) { atomicAdd(&bar[XB_TMO], 1u); break; } }
    }
    nloc = mine > 0u ? mine : 1u; nx = cnt > 0u ? cnt : 1u;
}

__device__ __forceinline__ void xcd_barrier(const XcdBarrier& b) {
    asm volatile("s_waitcnt vmcnt(0)" ::: "memory");
    __syncthreads();
    if (threadIdx.x == 0) {
        unsigned* bar = b.bar;
        __builtin_amdgcn_s_waitcnt(0);
        unsigned nloc = b.st[0], nx = b.st[1];
        if (nloc == 0u) { xcd_barrier_complete(bar, b.x, nloc, nx); b.st[0] = nloc; b.st[1] = nx; }
        const unsigned old = xb_add(&bar[XB_XSUB(b.x)], 1u);
        const unsigned gen = old / nloc;
        if (old + 1u == (gen + 1u) * nloc) {
            __builtin_amdgcn_fence(__ATOMIC_RELEASE, "agent");
            asm volatile("s_waitcnt vmcnt(0)" ::: "memory");
            const unsigned og = xb_add(&bar[XB_TOP], 1u);
            const unsigned tg = og / nx;
            if (og + 1u == (tg + 1u) * nx) xb_add(&bar[XB_TOPGEN], 1u);
            else XB_SPIN(xb_ld(&bar[XB_TOPGEN]) == tg, bar);
            __builtin_amdgcn_fence(__ATOMIC_ACQUIRE, "agent");
            xb_add(&bar[XB_XGEN(b.x)], 1u);
            asm volatile("s_waitcnt vmcnt(0)" ::: "memory");
        } else {
            XB_SPIN(xb_ld(&bar[XB_XGEN(b.x)]) == gen, bar);
            __builtin_amdgcn_fence(__ATOMIC_ACQUIRE, "agent");
            asm volatile("s_waitcnt vmcnt(0)" ::: "memory");
        }
    }
    __syncthreads();
}

__global__ void __launch_bounds__(NTHR, 2) fwd_kernel(Args A) {
    extern __shared__ __attribute__((aligned(16))) unsigned char lds_raw[];
    LAS unsigned char* lds = (LAS unsigned char*)lds_raw;
    cg::grid_group grid = cg::this_grid();
    const int wave_s = __builtin_amdgcn_readfirstlane((int)threadIdx.x >> 6);
    if (threadIdx.x < 32) ((LAS unsigned*)(lds + MISC_OFF))[threadIdx.x] = (threadIdx.x == 16) ? (unsigned)blockIdx.x : 0u;
    __syncthreads();
    (void)xcd_barrier_post((unsigned*)(A.ws + WS_CTL), (volatile LAS unsigned*)(lds + MISC_OFF) + 8);
#define OPQ_PTR(T, member) ({ unsigned long long p_; asm volatile("s_load_dwordx2 %0, %1, %2\n\ts_waitcnt lgkmcnt(0)" : "=s"(p_) : "s"(__builtin_amdgcn_kernarg_segment_ptr()), "i"((int)__builtin_offsetof(Args, member))); (T)p_; })
#define ws OPQ_PTR(unsigned char*, ws)
#define G ((int)gridDim.x)
#define bx ({ int b_; asm volatile("v_mov_b32 %0, %1\n\tds_read_b32 %0, %0\n\ts_waitcnt lgkmcnt(0)" : "=v"(b_) : "i"(MISC_OFF + 64)); __builtin_amdgcn_readfirstlane(b_); })
#define vcu ({ const int b_ = bx; (G % 8 == 0) ? (b_ % 8) * (G / 8) + b_ / 8 : b_; })
#define ngw (G * NWAVES)
#define H ((bf16_t*)(ws + WS_Y))
#define X16 ((bf16_t*)(ws + WS_H))
#define PROJ ((bf16_t*)(ws + WS_PROJ))
#define QM ((bf16_t*)(ws + WS_QM))
#define KVM ((bf16_t*)(ws + WS_KVM))
#define Y ((bf16_t*)(ws + WS_Y))
#define HID ((bf16_t*)(ws + WS_HID))
#define mod ((const float*)(ws + WS_MOD))
#define ropA ((const float*)(ws + WS_ROPA))
#define ropB ((const float*)(ws + WS_ROPB))
#define xres OPQ_PTR(float*, out)
#define XG ((bf16_t*)(ws + WS_XG))
#define SHW ((const float*)(ws + WS_SHW))
#define SSQ(l_, w_) ((pg8::ssq_t*)(ws + WS_SSQ) + ((size_t)(l_) * 8 + (w_)) * MTOK)
    int ph = 0;
#if MK_MULTI
#define PHASE_ON() (ph >= A.ph_lo && ph < A.ph_hi)
#define SEAM() do { if (ph >= A.ph_lo && ph + 1 < A.ph_hi) grid.sync(); ++ph; } while (0)
#else
#define PHASE_ON() (true)
#define SEAM() do { XcdBarrier xb_; xb_.bar = (unsigned*)(ws + WS_CTL); xb_.x = xb_xcc_id(); xb_.st = (volatile LAS unsigned*)(lds + MISC_OFF) + 8; xcd_barrier(xb_); } while (0)
#endif

    if (PHASE_ON() && EN_PRO) prologue(A, lds, vcu, G, wave_s);
    grid.sync();
    shw_tasks(mod, (const bf16_t*)(ws + WS_WIN), (const bf16_t*)(ws + WS_WGU), (float*)(ws + WS_SHW), vcu, ngw, wave_s);
    xg_pass(A.in[0], A.in[5], mod + 1 * DM, XG, X16, SSQ(0, 0), vcu, ngw, wave_s);
    SEAM();
#pragma unroll 1
    for (int l = 0; l < DEPTH; ++l) {
#define modl (mod + (size_t)l * 16 * NMOD)
#define xin ((l == 0) ? A.in[0] : (const float*)xres)
        if (PHASE_ON() && EN_P2) {
            pg8::Gemm g{XG, (const bf16_t*)(ws + WS_WIN) + l * WIN_L, MTOK, PJ, DM, DM}; pg8::StaticOrder S; S.init(MTOK, PJ, G, bx, REP_G2);
            pg8::EpiIn E{PROJ, ropA, ropB, SSQ(l, 0), SHW + (size_t)l * 16 * 7680, SSQ(l, 2), SSQ(l, 3)};
            pg8::gemm_phase<pg8::EpiIn, pg8::StaticOrder, true, true>(lds, g, S, E, wave_s);
        }
        SEAM();
        if (PHASE_ON()) {
            if (EN_P3A) { pg8::Gemm g{PROJ + PC_CQ, (const bf16_t*)(ws + WS_WUQ) + l * WUQ_L, MTOK, 768, 384, PJP}; pg8::StaticOrder S; S.init(MTOK, 768, G, bx, REP_G3);
              pg8::EpiUQ E{QM, SSQ(l, 2), ropB};
              pg8::gemm_phase<pg8::EpiUQ, pg8::StaticOrder, true, true>(lds, g, S, E, wave_s); }
            if (EN_P3B) { pg8::Gemm g{PROJ + PC_CKV, (const bf16_t*)(ws + WS_WUKV) + l * WUKV_L, MTOK, 768, 256, PJP}; pg8::StaticOrder S; S.init(MTOK, 768, G, bx, REP_G3);
              pg8::EpiUKV E{KVM, SSQ(l, 3)};
              pg8::gemm_phase<pg8::EpiUKV, pg8::StaticOrder, true, true>(lds, g, S, E, wave_s); }
            __syncthreads();
            if (EN_P3C) for (int u = vcu; u < NBATCH * 16 * 2; u += G) {
                const int kvh = u & 1, qb = (u >> 1) & 15, b = u >> 5;
                swa_unit3(lds, PROJ + (size_t)b * SEQ * PJP, Y + (size_t)b * SEQ * DM, qb * 256, kvh, A.in[7] + l * 6, SSQ(l, 4) + (size_t)b * SEQ, wave_s);
            }
            if (EN_P3D) for (int u_ = vcu; u_ < REP_SGU * NBATCH * 32; u_ += G) { const int u = u_ % (NBATCH * 32);
                sgu_unit(lds, PROJ, Y, (const bf16_t*)(ws + WS_WS) + l * WS_L, A.in[12] + l * 256, A.in[13] + l * 256, A.in[15] + l * 512, u * 128, SSQ(l, 6), wave_s); }
        }
        SEAM();
        if (PHASE_ON() && EN_P4) {
            for (int u_ = vcu; u_ < REP_P4 * NBATCH * 6 * 8; u_ += G) {
                const int u = u_ % (NBATCH * 6 * 8); const int s = u & 7, bh = u >> 3, b = bh / 6, h = bh % 6;
                const bf16_t* qb_ = QM + (size_t)b * SEQ * QMP + 96 * h;
                const bf16_t* kb_ = KVM + (size_t)b * SEQ * KVP + 128 * h;
                const bf16_t* kr_ = PROJ + (size_t)b * SEQ * PJP + PC_KR;
                bf16_t* ob_ = Y + (size_t)b * SEQ * DM + 384 + 64 * h;
                attn_unit<6, 0>(lds, qb_, QMP, kb_, KVP, kr_, PJP, kb_ + 64, KVP, ob_, DM, (15 - s) * 256, -1e30f, 0.f, (u_ >= NBATCH * 6 * 8 ? SSQ(l, 7) : SSQ(l, 5)) + (size_t)b * SEQ, wave_s);
                attn_unit<6, 0>(lds, qb_, QMP, kb_, KVP, kr_, PJP, kb_ + 64, KVP, ob_, DM, s * 256, -1e30f, 0.f, (u_ >= NBATCH * 6 * 8 ? SSQ(l, 7) : SSQ(l, 5)) + (size_t)b * SEQ, wave_s);
            }
        }
        SEAM();
        if (PHASE_ON() && EN_P6) {
            pg8::Gemm g{Y, (const bf16_t*)(ws + WS_WOUT) + l * WOUT_L, MTOK, DM, DM, DM}; pg8::StaticOrder S; S.init(MTOK, DM, G, bx);
#pragma unroll 1
            for (int rep_ = 0; rep_ < REP_P6; ++rep_) { const bool dmy = rep_ + 1 < REP_P6;
            pg8::EpiRes<true> E{X16, dmy ? PROJ : X16, modl + 2 * DM, dmy ? QM : XG, A.in[18] + l * DM, modl + 4 * DM, dmy ? (pg8::ssq_t*)(ws + 1008 * MiB) : SSQ(l, 1), SSQ(l, 4), SSQ(l, 5), SSQ(l, 6)};
            pg8::gemm_phase<pg8::EpiRes<true>, pg8::StaticOrder, true, true>(lds, g, S, E, wave_s); }
        }
        SEAM();
        if (PHASE_ON() && EN_P8) {
            pg8::Gemm g{XG, (const bf16_t*)(ws + WS_WGU) + l * WGU_L, MTOK, 2 * FFN, DM, DM}; pg8::StaticOrder S; S.init(MTOK, 2 * FFN, G, bx, REP_G8);
            pg8::EpiGU E{HID, SSQ(l, 1), SHW + (size_t)l * 16 * 7680 + PJ};
            pg8::gemm_phase<pg8::EpiGU, pg8::StaticOrder, true, true>(lds, g, S, E, wave_s);
        }
        SEAM();
        if (PHASE_ON() && EN_P9) {
            pg8::Gemm g{HID, (const bf16_t*)(ws + WS_WDN) + l * WDN_L, MTOK, DM, FFN, FFN}; pg8::StaticOrder S; S.init(MTOK, DM, G, bx);
            const int ln = (l + 1 < DEPTH) ? l + 1 : l;
#pragma unroll 1
            for (int rep_ = 0; rep_ < REP_P9; ++rep_) { const bool dmy = rep_ + 1 < REP_P9;
            pg8::EpiRes<false> E{X16, dmy ? Y : X16, modl + 5 * DM, (l + 1 < DEPTH) ? (dmy ? Y : XG) : (bf16_t*)nullptr, A.in[5] + ln * DM, mod + (size_t)ln * 16 * NMOD + 1 * DM, dmy ? SSQ(l, 7) : SSQ(ln, 0), nullptr, nullptr, nullptr};
            pg8::gemm_phase<pg8::EpiRes<false>, pg8::StaticOrder, true, true>(lds, g, S, E, wave_s); }
        }
        SEAM();
    }
    if (PHASE_ON() && EN_FIN) final_norm_pass(X16, xres, A.in[21], vcu, ngw, wave_s);
#undef PHASE_ON
#undef SEAM
#undef ws
#undef G
#undef bx
#undef vcu
#undef ngw
#undef H
#undef PROJ
#undef QM
#undef KVM
#undef Y
#undef HID
#undef mod
#undef ropA
#undef ropB
#undef xres
#undef modl
#undef xin
#undef X16
#undef XG
#undef SHW
#undef SSQ
}

extern "C" void kernel_launch(void* const* d_in, const int* in_sizes, int n_in, void* d_out, int out_size, void* d_ws, size_t ws_size, hipStream_t stream) {
    static int grid = 0;
    if (grid == 0) {
        if (n_in != 22 || out_size != MTOK * DM || ws_size < WS_END) { fprintf(stderr, "kernel_launch: unexpected shapes (n_in %d out %d ws %zu)\n", n_in, out_size, ws_size); grid = -1; return; }
        int dev = 0, cus = 0, per_cu = 0;
        hipGetDevice(&dev); hipDeviceGetAttribute(&cus, hipDeviceAttributeMultiprocessorCount, dev);
        if (hipFuncSetAttribute((const void*)fwd_kernel, hipFuncAttributeMaxDynamicSharedMemorySize, LDS_BYTES) != hipSuccess) { fprintf(stderr, "kernel_launch: hipFuncSetAttribute failed\n"); grid = -1; return; }
        if (hipOccupancyMaxActiveBlocksPerMultiprocessor(&per_cu, (const void*)fwd_kernel, NTHR, LDS_BYTES) != hipSuccess || per_cu < 1) { fprintf(stderr, "kernel_launch: occupancy query says %d\n", per_cu); per_cu = 1; }
        (void)hipGetLastError();
        grid = cus;
    }
    if (grid < 0) return;
    if (hipMemsetAsync((char*)d_ws + WS_CTL, 0, CTL_BYTES, stream) != hipSuccess) { fprintf(stderr, "kernel_launch: memset failed\n"); return; }
    Args a{};
    for (int i = 0; i < 22; ++i) a.in[i] = (const float*)d_in[i];
    a.out = (float*)d_out; a.ws = (unsigned char*)d_ws;
    for (int j = 0; j < 32; ++j) a.inv[j] = (float)(1.0 / pow(10000.0, (double)(2 * j) / 64.0));
    for (int j = 0; j < 16; ++j) a.inv[32 + j] = (float)(1.0 / pow(10000.0, (double)(2 * j) / 32.0));
#if MK_MULTI
    const int nph = 1 + DEPTH * 9 + 1;
    for (int p = 0; p < nph; ++p) { a.ph_lo = p; a.ph_hi = p + 1; hipLaunchKernelGGL(fwd_kernel, dim3(grid), dim3(NTHR), LDS_BYTES, stream, a); }
#else
    a.ph_lo = 0; a.ph_hi = 1 << 20;
    void* args[] = {&a};
    hipError_t e = hipLaunchCooperativeKernel((const void*)fwd_kernel, dim3(grid), dim3(NTHR), args, LDS_BYTES, stream);
    if (e != hipSuccess) fprintf(stderr, "cooperative launch failed: %s (grid %d)\n", hipGetErrorString(e), grid);
#endif
}
```
